# Optimizing an MI355X kernel written in HIP

```python
import jax, jax.numpy as jnp
from jax import lax
import numpy as np

D_MODEL = 1024
BATCH = 8
SEQ = 4096
DEPTH = 1

CHUNK = 64
EPS = 1e-6
N_HEADS_A = 8
HEAD_DIM_A = 64
D_A = N_HEADS_A * HEAD_DIM_A
N_PREV_CHUNKS = 8
BAND = (N_PREV_CHUNKS + 1) * CHUNK
REL_CLIP = 128
N_REL = 2 * REL_CLIP + 1
SGU_CHUNK = 128
N_GROUPS_B = 4
GROUP_DIM_B = 128
D_B = N_GROUPS_B * GROUP_DIM_B
SPLITS = (D_A, D_A, D_A, D_A, D_B, D_B, D_B, D_MODEL, D_MODEL)
D_IN = sum(SPLITS)
NEG_INF = -1e30

kernel_name = 'hybrid_chunked_attn_gmlp_gated'


def rmsnorm(x, g):
    xf = x.astype(jnp.float32)
    y = xf * lax.rsqrt(jnp.mean(xf * xf, axis=-1, keepdims=True) + EPS)
    return (y * g.astype(jnp.float32)).astype(x.dtype)


def layernorm(x, g, b):
    xf = x.astype(jnp.float32)
    mu = jnp.mean(xf, axis=-1, keepdims=True)
    var = jnp.mean(jnp.square(xf - mu), axis=-1, keepdims=True)
    y = (xf - mu) * lax.rsqrt(var + EPS)
    return (y * g.astype(jnp.float32) + b.astype(jnp.float32)).astype(x.dtype)


def chunked_rel_attention(q, k, v, rel_bias):
    b, s, _ = q.shape
    nc = s // CHUNK
    qc = q.reshape(b, nc, CHUNK, N_HEADS_A, HEAD_DIM_A)

    def band(t):
        t = t.reshape(b, nc, CHUNK, N_HEADS_A, HEAD_DIM_A)
        tp = jnp.pad(t, ((0, 0), (N_PREV_CHUNKS, 0), (0, 0), (0, 0), (0, 0)))
        return jnp.concatenate([tp[:, j:j + nc] for j in range(N_PREV_CHUNKS + 1)], axis=2)

    kb, vb = band(k), band(v)
    q_off = jnp.arange(CHUNK)
    k_off = jnp.arange(BAND) - N_PREV_CHUNKS * CHUNK
    dist = q_off[:, None] - k_off[None, :]
    bias = rel_bias[:, jnp.clip(dist, -REL_CLIP, REL_CLIP) + REL_CLIP].astype(jnp.float32)
    key_chunk = jnp.arange(nc)[:, None] + k_off[None, :] // CHUNK
    valid = key_chunk >= 0
    scale = HEAD_DIM_A ** -0.5
    scores = jnp.einsum('bnqhd,bnkhd->bhnqk', qc, kb).astype(jnp.float32) * scale
    scores = scores + bias[None, :, None, :, :]
    scores = jnp.where(valid[None, None, :, None, :], scores, NEG_INF)
    p = jax.nn.softmax(scores, axis=-1).astype(v.dtype)
    out = jnp.einsum('bhnqk,bnkhd->bnqhd', p, vb)
    return out.reshape(b, s, D_A)


def spatial_gating(u, v, ln_g, ln_b, w_s, b_s):
    b, s, _ = v.shape
    nb = s // SGU_CHUNK
    vn = layernorm(v, ln_g, ln_b).reshape(b, nb, SGU_CHUNK, N_GROUPS_B, GROUP_DIM_B)
    tri = jnp.tril(jnp.ones((SGU_CHUNK, SGU_CHUNK), dtype=bool))
    w = jnp.where(tri[None], w_s, jnp.zeros_like(w_s))
    mixed = jnp.einsum('gts,bnsgc->bntgc', w, vn) + jnp.transpose(b_s)[:, :, None]
    return u * mixed.reshape(b, s, D_B)


def hybrid_layer(x, norm_g, w_in, b_gate, rel_bias, sgu_ln_g, sgu_ln_b, w_s, b_s, w_pa, w_pb, w_out):
    h = rmsnorm(x, norm_g)
    z = jnp.einsum('bsd,de->bse', h, w_in)
    idx = list(np.cumsum(SPLITS)[:-1])
    q, k, v, g_a, u_b, v_b, g_b, gate_a, gate_b = jnp.split(z, idx, axis=-1)
    y_a = chunked_rel_attention(q, k, v, rel_bias) * jax.nn.silu(g_a)
    y_b = spatial_gating(jax.nn.gelu(u_b), jax.nn.gelu(v_b), sgu_ln_g, sgu_ln_b, w_s, b_s) * jax.nn.silu(g_b)
    p_a = jnp.einsum('bse,ed->bsd', y_a, w_pa)
    p_b = jnp.einsum('bse,ed->bsd', y_b, w_pb)
    ga = jax.nn.sigmoid(gate_a + b_gate[:D_MODEL])
    gb = jax.nn.sigmoid(gate_b + b_gate[D_MODEL:])
    merged = ga * p_a + gb * p_b
    return x + jnp.einsum('bsd,de->bse', merged, w_out)


def setup_inputs(seed: int = 0) -> dict:
    key = jax.random.key(seed)
    ks = jax.random.split(key, 16)
    f32 = jnp.float32
    nrm = lambda k, shape, s: jax.random.normal(k, shape, f32) * s
    return {
        'x': jax.random.normal(ks[0], (BATCH, SEQ, D_MODEL), f32),
        'norm_g': 1.0 + nrm(ks[1], (DEPTH, D_MODEL), 0.05),
        'w_in': nrm(ks[2], (DEPTH, D_MODEL, D_IN), D_MODEL ** -0.5),
        'b_gate': nrm(ks[3], (DEPTH, 2 * D_MODEL), 0.1),
        'rel_bias': nrm(ks[4], (DEPTH, N_HEADS_A, N_REL), 0.5),
        'sgu_ln_g': 1.0 + nrm(ks[5], (DEPTH, D_B), 0.05),
        'sgu_ln_b': nrm(ks[6], (DEPTH, D_B), 0.05),
        'w_s': nrm(ks[7], (DEPTH, N_GROUPS_B, SGU_CHUNK, SGU_CHUNK), SGU_CHUNK ** -0.5),
        'b_s': 1.0 + nrm(ks[8], (DEPTH, N_GROUPS_B, SGU_CHUNK), 0.1),
        'w_pa': nrm(ks[9], (DEPTH, D_A, D_MODEL), D_A ** -0.5),
        'w_pb': nrm(ks[10], (DEPTH, D_B, D_MODEL), D_B ** -0.5),
        'w_out': nrm(ks[11], (DEPTH, D_MODEL, D_MODEL), D_MODEL ** -0.5),
        'final_g': 1.0 + nrm(ks[12], (D_MODEL,), 0.05),
    }


def reference(x, norm_g, w_in, b_gate, rel_bias, sgu_ln_g, sgu_ln_b, w_s, b_s, w_pa, w_pb, w_out, final_g):
    for l in range(DEPTH):
        x = hybrid_layer(x, norm_g[l], w_in[l], b_gate[l], rel_bias[l], sgu_ln_g[l], sgu_ln_b[l],
                         w_s[l], b_s[l], w_pa[l], w_pb[l], w_out[l])
    return rmsnorm(x, final_g)
```

```cpp
#include <hip/hip_runtime.h>
#include <hip/hip_cooperative_groups.h>
#include <cstdio>
#include <cstdint>
namespace cg = cooperative_groups;
constexpr int NWAVES = 8;
constexpr int BATCH = 8, SEQ = 4096, D = 1024, M = BATCH * SEQ;
constexpr int DA = 512, DB = 512, DIN = 5632, NH = 8, HD = 64, NREL = 257;
constexpr float EPS = 1e-6f;
constexpr size_t MiB = 1u << 20;
constexpr size_t WS_RSTD = 1 * MiB;
constexpr size_t WS_WSB = 1 * MiB + 512 * 1024;
constexpr size_t WS_ROWSS = 2 * MiB;
constexpr size_t WS_WIN = 4 * MiB;
constexpr size_t WS_WP = 16 * MiB;
constexpr size_t WS_WO = 18 * MiB;
constexpr size_t WS_XB = 32 * MiB;
constexpr size_t WS_UB = 96 * MiB, WS_VB = 128 * MiB, WS_GB = 160 * MiB;
constexpr size_t WS_GTA = 192 * MiB, WS_GTB = 256 * MiB;
constexpr size_t WS_Y = 320 * MiB;
constexpr size_t WS_MRG = 384 * MiB;
constexpr size_t WS_END = 448 * MiB;
constexpr size_t DO_Q = 0, DO_K = 32 * MiB, DO_VT = 64 * MiB, DO_GA = 96 * MiB;

namespace pg8 {
#define PG8_LAS __attribute__((address_space(3)))
typedef unsigned short bf16_t;
typedef short bf16x8 __attribute__((ext_vector_type(8)));
typedef float f32x4 __attribute__((ext_vector_type(4)));
typedef unsigned u32x4 __attribute__((ext_vector_type(4)));
constexpr int BM = 256, BK = 64, HALF = 128, HTB = HALF * BK * 2  , STAGE_BYTES = 8 * HTB, NXCD = 8, WGM = 8;

__host__ __device__ __forceinline__ int lds_byte(int r, int c) { const int st = (r >> 4) * 2 + (c >> 5), rr = r & 15, cc = c & 31, ob = rr * 64 + cc * 2; return st * 1024 + (ob ^ (((ob >> 9) & 1) << 5)); }
__host__ __device__ __forceinline__ void stage_rc(int b, int& R, int& C) { const int st = b / 1024, sb = b % 1024, swz = sb ^ (((sb >> 9) & 1) << 5); R = (st >> 1) * 16 + swz / 64; C = (st & 1) * 32 + (swz % 64) / 2; }
__host__ __device__ __forceinline__ int perm32(int rho) { const int n = rho >> 4, i = rho & 15; return 8 * (i >> 2) + 4 * n + (i & 3); }

struct Unit { int pm, pn, kh; };
struct Gemm { const bf16_t* A; const bf16_t* Bt; int M, N, K, nt; size_t khstep; };

struct StaticOrder {
    int nM, nN, nwg, G, c;
    __host__ __device__ void init(int M, int N, int G_, int c_) { nM = M / BM; nN = N / BM; nwg = nM * nN; G = G_; c = c_; }
    __host__ __device__ bool next(int i, Unit& u) const {
        const long L = (long)i * G + c; if (L >= nwg) return false;
        int wgid = (int)L; { const int q = nwg / NXCD, r = nwg % NXCD, xcd = wgid % NXCD, off = wgid / NXCD; wgid = (xcd < r ? xcd * (q + 1) : r * (q + 1) + (xcd - r) * q) + off; }
        const int nig = WGM * nN, gid = wgid / nig, fm = gid * WGM, gsz = (nM - fm) < WGM ? (nM - fm) : WGM;
        u.pm = fm + ((wgid % nig) % gsz); u.pn = (wgid % nig) / gsz; u.kh = 0; return true;
    }
    __device__ __forceinline__ void a_ready(const Unit&) const {}
    __device__ __forceinline__ void done(const Unit&) const {}
};
struct SplitKOrder { StaticOrder B;
    __device__ bool next(int i, Unit& u) const { if (!B.next(i >> 1, u)) return false; u.kh = i & 1; return true; }
    __device__ __forceinline__ void a_ready(const Unit&) const {}
    __device__ __forceinline__ void done(const Unit&) const {}
};
typedef float f32x2_cv __attribute__((ext_vector_type(2))); typedef __bf16 bf16x2_cv __attribute__((ext_vector_type(2)));
__device__ __forceinline__ unsigned cvt_pk_bf16(float lo, float hi) { const f32x2_cv v = {lo, hi}; const bf16x2_cv b = __builtin_convertvector(v, bf16x2_cv); return __builtin_bit_cast(unsigned, b); }
typedef float f32x2 __attribute__((ext_vector_type(2)));

constexpr float LOG2E = 1.4426950408889634f;
constexpr float QSCALE = 0.125f * LOG2E;
__device__ __forceinline__ float sigm(float t) { return __builtin_amdgcn_rcpf(1.0f + __builtin_amdgcn_exp2f(-LOG2E * t)); }
__device__ __forceinline__ float bf_lo(unsigned w) { return __uint_as_float(w << 16); }
__device__ __forceinline__ float bf_hi(unsigned w) { return __uint_as_float(w & 0xffff0000u); }

struct EpiIn {
    static constexpr bool PERM = true, AFTER_DRAIN = false, MID = false;
    const float* rstd; const float* b_gate;
    unsigned char* ws; unsigned char* dout;
    __device__ __forceinline__ void operator()(const f32x4 (&acc)[2][2][4][2], const Unit& u, int wr, int wc, int fr, int fq) const {
        const int pn = u.pn, row0 = u.pm * BM + wr * 64 + fr, lc = wc * 32 + 8 * fq;
        if (pn < 4) {
            bf16_t* base = (bf16_t*)(dout + (pn < 2 ? DO_Q : DO_K)); const float sc = pn < 2 ? QSCALE : 1.0f; const int col0 = (pn & 1) * 256 + lc;
#pragma unroll
            for (int ai = 0; ai < 2; ++ai)
#pragma unroll
                for (int m = 0; m < 4; ++m) { bf16_t* rowp = base + (size_t)(row0 + ai * HALF + m * 16) * 512 + col0; const float s = rstd[row0 + ai * HALF + m * 16] * sc;
#pragma unroll
                    for (int bj = 0; bj < 2; ++bj) { const f32x4 v0 = acc[ai][bj][m][0] * s, v1 = acc[ai][bj][m][1] * s;
                        u32x4 w; w.x = cvt_pk_bf16(v0[0], v0[1]); w.y = cvt_pk_bf16(v0[2], v0[3]); w.z = cvt_pk_bf16(v1[0], v1[1]); w.w = cvt_pk_bf16(v1[2], v1[3]);
                        *(u32x4*)(rowp + bj * HALF) = w; } }
        } else if (pn < 6) {
#pragma unroll
            for (int ai = 0; ai < 2; ++ai)
#pragma unroll
                for (int m = 0; m < 4; ++m) { const int row = row0 + ai * HALF + m * 16, b = row >> 12, t = row & 4095; const float s = rstd[row0 + ai * HALF + m * 16];
#pragma unroll
                    for (int bj = 0; bj < 2; ++bj) { const int c0 = (pn - 4) * 256 + bj * HALF + lc;
                        bf16_t* p = (bf16_t*)(dout + DO_VT) + (((size_t)(b * 512 + c0)) << 12) + t;
#pragma unroll
                        for (int n = 0; n < 2; ++n)
#pragma unroll
                            for (int i = 0; i < 4; i += 2) { const unsigned w = cvt_pk_bf16(acc[ai][bj][m][n][i] * s, acc[ai][bj][m][n][i + 1] * s);
                                p[(size_t)(4 * n + i) << 12] = (bf16_t)(w & 0xffffu); p[(size_t)(4 * n + i + 1) << 12] = (bf16_t)(w >> 16); } } }
        } else if (pn < 14) {
            const int seg = (pn - 6) >> 1; bf16_t* base = (bf16_t*)(seg == 0 ? dout + DO_GA : ws + WS_UB + (size_t)(seg - 1) * (WS_VB - WS_UB));
            const bool gl = (seg == 1 || seg == 2); const float a1 = gl ? 1.5957691216057308f : 1.0f, a3 = gl ? 1.5957691216057308f * 0.044715f : 0.0f;
            const int col0 = (pn & 1) * 256 + lc;
#pragma unroll
            for (int ai = 0; ai < 2; ++ai)
#pragma unroll
                for (int m = 0; m < 4; ++m) { bf16_t* rowp = base + (size_t)(row0 + ai * HALF + m * 16) * 512 + col0; const float s = rstd[row0 + ai * HALF + m * 16];
#pragma unroll
                    for (int bj = 0; bj < 2; ++bj) { float o[8];
#pragma unroll
                        for (int n = 0; n < 2; ++n)
#pragma unroll
                            for (int i = 0; i < 4; ++i) { const float v = acc[ai][bj][m][n][i] * s; o[4 * n + i] = v * sigm(v * (a1 + a3 * v * v)); }
                        u32x4 w; w.x = cvt_pk_bf16(o[0], o[1]); w.y = cvt_pk_bf16(o[2], o[3]); w.z = cvt_pk_bf16(o[4], o[5]); w.w = cvt_pk_bf16(o[6], o[7]);
                        *(u32x4*)(rowp + bj * HALF) = w; } }
        } else {
            bf16_t* base = (bf16_t*)(ws + (pn < 18 ? WS_GTA : WS_GTB)); const int col0 = ((pn - 14) & 3) * 256 + lc, bcol0 = (pn - 14) * 256 + lc;
#pragma unroll
            for (int ai = 0; ai < 2; ++ai)
#pragma unroll
                for (int m = 0; m < 4; ++m) { bf16_t* rowp = base + (size_t)(row0 + ai * HALF + m * 16) * 1024 + col0; const float s = rstd[row0 + ai * HALF + m * 16];
#pragma unroll
                    for (int bj = 0; bj < 2; ++bj) { float o[8];
#pragma unroll
                        for (int n = 0; n < 2; ++n) { const f32x4 bvv = *(const f32x4*)(b_gate + bcol0 + bj * HALF + 4 * n);
#pragma unroll
                            for (int i = 0; i < 4; ++i) o[4 * n + i] = sigm(acc[ai][bj][m][n][i] * s + bvv[i]); }
                        u32x4 w; w.x = cvt_pk_bf16(o[0], o[1]); w.y = cvt_pk_bf16(o[2], o[3]); w.z = cvt_pk_bf16(o[4], o[5]); w.w = cvt_pk_bf16(o[6], o[7]);
                        *(u32x4*)(rowp + bj * HALF) = w; } }
        }
    }
};

struct EpiMerge {
    static constexpr bool PERM = true, AFTER_DRAIN = false, MID = true;
    const bf16_t *GTA, *GTB; bf16_t* O;
    __device__ __forceinline__ void mid(f32x4 (&acc)[2][2][4][2], const Unit& u, int wr, int wc, int fr, int fq) const {
        const int row0 = u.pm * BM + wr * 64 + fr, col0 = u.pn * BM + wc * 32 + 8 * fq;
#pragma unroll
        for (int ai = 0; ai < 2; ++ai)
#pragma unroll
            for (int m = 0; m < 4; ++m) { const size_t off = (size_t)(row0 + ai * HALF + m * 16) * 1024 + col0;
#pragma unroll
                for (int bj = 0; bj < 2; ++bj) { const u32x4 a = *(const u32x4*)(GTA + off + bj * HALF), b = *(const u32x4*)(GTB + off + bj * HALF);
#pragma unroll
                    for (int j = 0; j < 4; ++j) { const float r0 = bf_lo(a[j]) * __builtin_amdgcn_rcpf(bf_lo(b[j])), r1 = bf_hi(a[j]) * __builtin_amdgcn_rcpf(bf_hi(b[j]));
                        acc[ai][bj][m][j >> 1][(j & 1) * 2] *= r0; acc[ai][bj][m][j >> 1][(j & 1) * 2 + 1] *= r1; } }
                asm volatile("" ::: "memory"); }
    }
    __device__ __forceinline__ void operator()(const f32x4 (&acc)[2][2][4][2], const Unit& u, int wr, int wc, int fr, int fq) const {
        const int row0 = u.pm * BM + wr * 64 + fr, col0 = u.pn * BM + wc * 32 + 8 * fq;
#pragma unroll
        for (int ai = 0; ai < 2; ++ai)
#pragma unroll
            for (int m = 0; m < 4; ++m) { const size_t off = (size_t)(row0 + ai * HALF + m * 16) * 1024 + col0;
#pragma unroll
                for (int bj = 0; bj < 2; ++bj) { const u32x4 b = *(const u32x4*)(GTB + off + bj * HALF); u32x4 w;
#pragma unroll
                    for (int j = 0; j < 4; ++j) w[j] = cvt_pk_bf16(acc[ai][bj][m][j >> 1][(j & 1) * 2] * bf_lo(b[j]), acc[ai][bj][m][j >> 1][(j & 1) * 2 + 1] * bf_hi(b[j]));
                    *(u32x4*)(O + off + bj * HALF) = w; } }
    }
};

struct EpiOut {
    static constexpr bool PERM = false, AFTER_DRAIN = false, MID = false;
    const float* x; const float* fg; float* out; float* rowss;
    __device__ __forceinline__ void operator()(const f32x4 (&acc)[2][2][4][2], const Unit& u, int wr, int wc, int fr, int fq) const {
        const int row0 = u.pm * BM + wr * 64 + fr, col0 = u.pn * BM + wc * 32 + 4 * fq;
        f32x4 gv[2][2];
#pragma unroll
        for (int bj = 0; bj < 2; ++bj)
#pragma unroll
            for (int n = 0; n < 2; ++n) gv[bj][n] = *(const f32x4*)(fg + col0 + bj * HALF + n * 16);
#pragma unroll
        for (int ai = 0; ai < 2; ++ai)
#pragma unroll
            for (int m = 0; m < 4; ++m) { const int row = row0 + ai * HALF + m * 16; const size_t off = (size_t)row * 1024 + col0; float ss = 0.f;
#pragma unroll
                for (int bj = 0; bj < 2; ++bj)
#pragma unroll
                    for (int n = 0; n < 2; ++n) { const f32x4 v = acc[ai][bj][m][n] + *(const f32x4*)(x + off + bj * HALF + n * 16);
                        ss += (v[0] * v[0] + v[1] * v[1]) + (v[2] * v[2] + v[3] * v[3]); *(f32x4*)(out + off + bj * HALF + n * 16) = v * gv[bj][n]; }
                ss += __shfl_xor(ss, 16); ss += __shfl_xor(ss, 32);
                if (fq == 0) rowss[((size_t)u.pn * 32768 + row) * 4 + wc] = ss; }
    }
};
template <class Epi, class Sched, bool ALIGN_EPI = false, bool SP2 = false>
__device__ __forceinline__ void gemm_phase(PG8_LAS unsigned char* lds, const Gemm g, const Sched& S, const Epi& E) {
    const int tid = threadIdx.x, wid = __builtin_amdgcn_readfirstlane(tid >> 6), lane = tid & 63, wr = wid >> 2, wc = wid & 3, fr = lane & 15, fq = lane >> 4;
    const int K = g.K, nt = g.nt;
    unsigned voffA[2], voffB[2];
#pragma unroll
    for (int i = 0; i < 2; ++i) { int R, C; stage_rc(tid * 16 + i * 8192, R, C); const int Rb = Epi::PERM ? ((R & ~31) + perm32(R & 31)) : R;
        voffA[i] = (unsigned)(R * K + C) * 2u; voffB[i] = (unsigned)(Rb * K + C) * 2u; }
    const size_t kstep = (size_t)(BK * 2);
    const size_t hstep = (size_t)HALF * K * 2;
    const size_t tstep = 2 * hstep;
    const unsigned ldsw = (unsigned)wid * 1024u;
    const int aoff = lds_byte(wr * 64 + fr, fq * 8), boff = lds_byte(wc * 32 + fr, fq * 8);
#define PG8_SA(b, h) (((b) * 2 + (h)) * HTB)
#define PG8_SB(b, h) ((4 + (b) * 2 + (h)) * HTB)
#define PG8_STAGE(bufoff, gbase, voff) do { _Pragma("unroll") for (int _i = 0; _i < 2; ++_i) \
        __builtin_amdgcn_global_load_lds((const unsigned*)((const char*)(gbase) + (voff)[_i]), (PG8_LAS unsigned*)(lds + (bufoff) + ldsw + _i * 8192), 16, 0, 0); } while (0)
#define PG8_LDA(dst, b, h) do { _Pragma("unroll") for (int m = 0; m < 4; ++m) _Pragma("unroll") for (int k = 0; k < 2; ++k) dst[m][k] = *(const PG8_LAS bf16x8*)(lds + PG8_SA(b, h) + aoff + m * 2048 + k * 1024); } while (0)
#define PG8_LDB(dst, b, h) do { _Pragma("unroll") for (int n = 0; n < 2; ++n) _Pragma("unroll") for (int k = 0; k < 2; ++k) dst[n][k] = *(const PG8_LAS bf16x8*)(lds + PG8_SB(b, h) + boff + n * 2048 + k * 1024); } while (0)
#define PG8_MMA(ai, bj, At, Bt) do { __builtin_amdgcn_s_setprio(1); _Pragma("unroll") for (int m = 0; m < 4; ++m) _Pragma("unroll") for (int n = 0; n < 2; ++n) _Pragma("unroll") for (int k = 0; k < 2; ++k) \
        acc[ai][bj][m][n] = __builtin_amdgcn_mfma_f32_16x16x32_bf16(Bt[n][k], At[m][k], acc[ai][bj][m][n], 0, 0, 0); __builtin_amdgcn_s_setprio(0); } while (0)
#define PG8_WAIT_V(n) asm volatile("s_waitcnt vmcnt(" #n ")" ::: "memory")
#define PG8_WAIT_L(n) asm volatile("s_waitcnt lgkmcnt(" #n ")" ::: "memory")
#define PG8_BAR __builtin_amdgcn_s_barrier()
#define PG8_SCHED __builtin_amdgcn_sched_barrier(0)
    Unit cur, nxt; int ui = 0;
    if (!S.next(0, cur)) return;
    f32x4 acc[2][2][4][2];
#pragma unroll
    for (int a = 0; a < 2; ++a)
#pragma unroll
        for (int b = 0; b < 2; ++b)
#pragma unroll
            for (int m = 0; m < 4; ++m)
#pragma unroll
                for (int n = 0; n < 2; ++n) acc[a][b][m][n] = (f32x4){0.f, 0.f, 0.f, 0.f};
    bf16x8 At[4][2], B0[2][2], B1[2][2];
    const char* cA = (const char*)g.A + (size_t)cur.pm * tstep + (size_t)cur.kh * g.khstep; const char* cB = (const char*)g.Bt + (size_t)cur.pn * tstep + (size_t)cur.kh * g.khstep;
    S.a_ready(cur);
    if constexpr (SP2) {
        PG8_STAGE(PG8_SB(0, 0), cB, voffB); PG8_STAGE(PG8_SB(0, 1), cB + hstep, voffB); PG8_STAGE(PG8_SA(0, 0), cA, voffA); PG8_STAGE(PG8_SA(0, 1), cA + hstep, voffA);
        if (wr == 1) PG8_BAR;
        PG8_WAIT_V(2); PG8_BAR;
        PG8_STAGE(PG8_SB(1, 0), cB + kstep, voffB); PG8_STAGE(PG8_SA(1, 0), cA + kstep, voffA); PG8_STAGE(PG8_SB(1, 1), cB + hstep + kstep, voffB);
        PG8_WAIT_V(6); PG8_BAR;
    } else {
        PG8_STAGE(PG8_SB(0, 0), cB, voffB); PG8_STAGE(PG8_SA(0, 0), cA, voffA); PG8_STAGE(PG8_SB(0, 1), cB + hstep, voffB); PG8_STAGE(PG8_SA(0, 1), cA + hstep, voffA);
        if (wr == 1) PG8_BAR;
        PG8_WAIT_V(4); PG8_BAR;
        PG8_STAGE(PG8_SB(1, 0), cB + kstep, voffB); PG8_STAGE(PG8_SA(1, 0), cA + kstep, voffA); PG8_STAGE(PG8_SB(1, 1), cB + hstep + kstep, voffB);
        PG8_WAIT_V(6); PG8_BAR;
    }
    for (;;) {
        const bool has_next = S.next(ui + 1, nxt);
        const char* nA = has_next ? (const char*)g.A + (size_t)nxt.pm * tstep + (size_t)nxt.kh * g.khstep : cA; const char* nB = has_next ? (const char*)g.Bt + (size_t)nxt.pn * tstep + (size_t)nxt.kh * g.khstep : cB;
        for (int t = 0; t < nt; t += 2) {
            const bool last = (t == nt - 2);
            const char* a1 = cA + (size_t)(t + 1) * kstep;
            const char* a2 = last ? nA : cA + (size_t)(t + 2) * kstep; const char* b2 = last ? nB : cB + (size_t)(t + 2) * kstep;
            const char* a3 = a2 + kstep; const char* b3 = b2 + kstep;
            if (last && has_next) S.a_ready(nxt);
            if constexpr (SP2) {
            PG8_LDB(B0, 0, 0); PG8_LDB(B1, 0, 1); PG8_SCHED; PG8_LDA(At, 0, 0); PG8_STAGE(PG8_SA(1, 1), a1 + hstep, voffA);
            PG8_WAIT_V(8); PG8_WAIT_L(0); PG8_BAR; PG8_MMA(0, 0, At, B0); PG8_MMA(0, 1, At, B1); PG8_BAR; PG8_SCHED;
            PG8_LDA(At, 0, 1); PG8_STAGE(PG8_SB(0, 0), b2, voffB); PG8_STAGE(PG8_SB(0, 1), b2 + hstep, voffB); PG8_STAGE(PG8_SA(0, 0), a2, voffA);
            PG8_WAIT_V(8); PG8_WAIT_L(0); PG8_BAR; PG8_MMA(1, 0, At, B0); PG8_MMA(1, 1, At, B1); PG8_BAR; PG8_SCHED;
            PG8_LDB(B0, 1, 0); PG8_LDB(B1, 1, 1); PG8_SCHED; PG8_LDA(At, 1, 0); PG8_STAGE(PG8_SA(0, 1), a2 + hstep, voffA);
            PG8_WAIT_V(8); PG8_WAIT_L(0); PG8_BAR; PG8_MMA(0, 0, At, B0); PG8_MMA(0, 1, At, B1); PG8_BAR; PG8_SCHED;
            PG8_LDA(At, 1, 1); PG8_STAGE(PG8_SB(1, 0), b3, voffB); PG8_STAGE(PG8_SB(1, 1), b3 + hstep, voffB); PG8_STAGE(PG8_SA(1, 0), a3, voffA);
            PG8_WAIT_V(8); PG8_WAIT_L(0); PG8_BAR; PG8_MMA(1, 0, At, B0); PG8_MMA(1, 1, At, B1); PG8_BAR; PG8_SCHED;
            } else {
            PG8_LDB(B0, 0, 0); PG8_SCHED; PG8_LDA(At, 0, 0); PG8_STAGE(PG8_SA(1, 1), a1 + hstep, voffA);
            PG8_WAIT_L(8); PG8_BAR; PG8_WAIT_L(0); PG8_MMA(0, 0, At, B0); PG8_BAR; PG8_SCHED;
            PG8_LDB(B1, 0, 1); PG8_STAGE(PG8_SB(0, 0), b2, voffB);
            PG8_BAR; PG8_WAIT_L(0); PG8_MMA(0, 1, At, B1); PG8_BAR;
            PG8_LDA(At, 0, 1); PG8_STAGE(PG8_SA(0, 0), a2, voffA);
            PG8_BAR; PG8_WAIT_L(0); PG8_MMA(1, 0, At, B0); PG8_BAR; PG8_SCHED;
            PG8_STAGE(PG8_SB(0, 1), b2 + hstep, voffB);
            PG8_WAIT_V(6); PG8_BAR; PG8_MMA(1, 1, At, B1); PG8_BAR;
            PG8_LDB(B0, 1, 0); PG8_SCHED; PG8_LDA(At, 1, 0); PG8_STAGE(PG8_SA(0, 1), a2 + hstep, voffA);
            PG8_WAIT_L(8); PG8_BAR; PG8_WAIT_L(0); PG8_MMA(0, 0, At, B0); PG8_BAR; PG8_SCHED;
            PG8_LDB(B1, 1, 1); PG8_STAGE(PG8_SB(1, 0), b3, voffB);
            PG8_BAR; PG8_WAIT_L(0); PG8_MMA(0, 1, At, B1); PG8_BAR;
            PG8_LDA(At, 1, 1); PG8_STAGE(PG8_SA(1, 0), a3, voffA);
            PG8_BAR; PG8_WAIT_L(0); PG8_MMA(1, 0, At, B0); PG8_BAR; PG8_SCHED;
            PG8_STAGE(PG8_SB(1, 1), b3 + hstep, voffB);
            PG8_WAIT_V(6); PG8_BAR; PG8_MMA(1, 1, At, B1); PG8_BAR;
            }
        }
        if constexpr (ALIGN_EPI) { if (wr == 0) PG8_BAR; }
        bool keep = false;
        if constexpr (Epi::MID) { if (cur.kh == 0) { E.mid(acc, cur, wr, wc, fr, fq); keep = true; } else E(acc, cur, wr, wc, fr, fq); }
        else if constexpr (!Epi::AFTER_DRAIN) { E(acc, cur, wr, wc, fr, fq); S.done(cur); }
        if (!has_next) break;
        if (!keep)
#pragma unroll
        for (int a = 0; a < 2; ++a)
#pragma unroll
            for (int b = 0; b < 2; ++b)
#pragma unroll
                for (int m = 0; m < 4; ++m)
#pragma unroll
                    for (int n = 0; n < 2; ++n) acc[a][b][m][n] = (f32x4){0.f, 0.f, 0.f, 0.f};
        cur = nxt; cA = nA; cB = nB; ++ui;
        if constexpr (ALIGN_EPI) { if (wr == 1) PG8_BAR; }
    }
    PG8_WAIT_V(0);
    if constexpr (!ALIGN_EPI) { if (wr == 0) PG8_BAR; }
    PG8_BAR;
    if constexpr (Epi::AFTER_DRAIN) { E.fused(acc, cur, wr, wc, fr, fq, lds, wid, lane); S.done(cur); }
#undef PG8_SA
#undef PG8_SB
#undef PG8_STAGE
#undef PG8_LDA
#undef PG8_LDB
#undef PG8_MMA
#undef PG8_WAIT_V
#undef PG8_WAIT_L
#undef PG8_BAR
#undef PG8_SCHED
}
}

#ifndef PG8_SP2
#define PG8_SP2 true
#endif
#ifndef PG8_ALIGN
#define PG8_ALIGN true
#endif
#ifndef REP_PHASE
#define REP_PHASE (-1)
#endif

constexpr int LDS_BYTES = 147456;

#define GAS __attribute__((address_space(1)))
#define LAS __attribute__((address_space(3)))
typedef unsigned short bf16;
typedef unsigned v4u __attribute__((ext_vector_type(4)));
typedef unsigned v2u __attribute__((ext_vector_type(2)));
typedef float f32x4 __attribute__((ext_vector_type(4)));
typedef float f32x16 __attribute__((ext_vector_type(16)));
typedef short bf16x8 __attribute__((ext_vector_type(8)));
using pg8::cvt_pk_bf16; using pg8::bf_lo; using pg8::bf_hi; using pg8::LOG2E;
#define LDS_WAIT() asm volatile("s_waitcnt lgkmcnt(0)" ::: "memory")
__device__ __forceinline__ unsigned f2bf(float f) { unsigned u = __builtin_bit_cast(unsigned, f); return (u + 0x7fffu + ((u >> 16) & 1u)) >> 16; }
__device__ __forceinline__ unsigned pk2(float lo, float hi) { return f2bf(lo) | (f2bf(hi) << 16); }
__device__ __forceinline__ float wave_sum(float v) {
#pragma unroll
    for (int o = 1; o < 64; o <<= 1) v += __shfl_xor(v, o);
    return v;
}
__device__ __forceinline__ int crow(int r, int hi) { return (r & 3) + 8 * (r >> 2) + 4 * hi; }

struct Args { const float* in[13]; float* out; unsigned char* ws; int ph_lo, ph_hi; };

__device__ __forceinline__ void p0_transpose_item(const float* W, int N, bf16* WT, int ldo, int koff, const float* scale, LAS float* scr, int item, int lane) {
    const int nblk = N / 32, kb = item / nblk, nb = item % nblk, k0 = 64 * kb, n0 = 32 * nb;
#pragma unroll 8
    for (int i = 0; i < 32; ++i) { const int kk = 2 * i + (lane >> 5); const float sc = scale ? scale[k0 + kk] : 1.0f; scr[kk * 33 + (lane & 31)] = W[(size_t)(k0 + kk) * N + n0 + (lane & 31)] * sc; }
    LDS_WAIT(); asm volatile("" ::: "memory");
    const int c = lane & 7;
#pragma unroll
    for (int j = 0; j < 4; ++j) { const int n = (lane >> 3) + 8 * j; const LAS float* s = scr + (8 * c) * 33 + n;
        v4u o; o.x = pk2(s[0 * 33], s[1 * 33]); o.y = pk2(s[2 * 33], s[3 * 33]); o.z = pk2(s[4 * 33], s[5 * 33]); o.w = pk2(s[6 * 33], s[7 * 33]);
        *(GAS v4u*)(WT + (size_t)(n0 + n) * ldo + koff + k0 + 8 * c) = o; }
    LDS_WAIT(); asm volatile("" ::: "memory");
}
__device__ __forceinline__ void p0_prologue(const Args& a, LAS unsigned char* lds, int gw, int NGW, int wave, int lane) {
    unsigned char* ws = a.ws;
    LAS float* scr = (LAS float*)(lds + wave * 16384);
    constexpr int I_IN = (D / 64) * (DIN / 32), I_P = (512 / 64) * (D / 32), I_O = (D / 64) * (D / 32);
    constexpr int NITEMS = I_IN + 2 * I_P + I_O;
    for (int it = gw; it < NITEMS; it += NGW) {
        int r = it;
        if (r < I_IN) { p0_transpose_item(a.in[2], DIN, (bf16*)(ws + WS_WIN), D, 0, a.in[1], scr, r, lane); continue; } r -= I_IN;
        if (r < I_P) { p0_transpose_item(a.in[9], D, (bf16*)(ws + WS_WP), D, 0, nullptr, scr, r, lane); continue; } r -= I_P;
        if (r < I_P) { p0_transpose_item(a.in[10], D, (bf16*)(ws + WS_WP), D, 512, nullptr, scr, r, lane); continue; } r -= I_P;
        p0_transpose_item(a.in[11], D, (bf16*)(ws + WS_WO), D, 0, nullptr, scr, r, lane);
    }
    { const float* w = a.in[7]; bf16* o = (bf16*)(ws + WS_WSB);
      for (int i = gw * 64 + lane; i < 4 * 128 * 128; i += NGW * 64) { const int t = (i >> 7) & 127, s = i & 127; o[i] = (bf16)f2bf(s <= t ? w[i] : 0.0f); } }
    const float* x = a.in[0]; bf16* xb = (bf16*)(ws + WS_XB); float* rstd = (float*)(ws + WS_RSTD);
    const int rows_per = (M + NGW - 1) / NGW;
    for (int m = gw * rows_per; m < M && m < (gw + 1) * rows_per; ++m) {
        const GAS f32x4* xr = (const GAS f32x4*)(x + (size_t)m * D) + lane;
        f32x4 v[4]; float s = 0.f;
#pragma unroll
        for (int j = 0; j < 4; ++j) { v[j] = xr[64 * j]; s += (v[j].x * v[j].x + v[j].y * v[j].y) + (v[j].z * v[j].z + v[j].w * v[j].w); }
        s = wave_sum(s);
        if (lane == 0) rstd[m] = 1.0f / sqrtf(s * (1.0f / D) + EPS);
        GAS unsigned long long* o8 = (GAS unsigned long long*)(xb + (size_t)m * D) + lane;
#pragma unroll
        for (int j = 0; j < 4; ++j) o8[64 * j] = (unsigned long long)pk2(v[j].x, v[j].y) | ((unsigned long long)pk2(v[j].z, v[j].w) << 32);
    }
}

__device__ __forceinline__ void attn_phase(const bf16* Q, const bf16* Kb, const bf16* Vt, const bf16* GA, bf16* Y, const float* rel_bias, LAS float* tab, int gw, int NGW, int tid, int lane) {
    for (int i = tid; i < NH * NREL; i += NWAVES * 64) { const int h = i / NREL, j = i - h * NREL; tab[h * 260 + j] = rel_bias[i] * LOG2E; }
    __syncthreads();
    const int r32 = lane & 31, hi = lane >> 5;
    for (int item = gw; item < BATCH * NH * 64; item += NGW) {
        const int bh = item >> 6, c = item & 63, b = bh >> 3, h = bh & 7;
        const int tok0 = b * SEQ + c * 64;
        bf16x8 qf[2][4];
#pragma unroll
        for (int qb = 0; qb < 2; ++qb)
#pragma unroll
            for (int d0 = 0; d0 < 4; ++d0) qf[qb][d0] = *(const bf16x8*)(Q + (size_t)(tok0 + qb * 32 + r32) * 512 + h * 64 + d0 * 16 + hi * 8);
        f32x16 o[2][2];
#pragma unroll
        for (int x = 0; x < 2; ++x)
#pragma unroll
            for (int y = 0; y < 2; ++y)
#pragma unroll
                for (int i = 0; i < 16; ++i) o[x][y][i] = 0.f;
        float mrow[2] = {-1e30f, -1e30f}, lrow[2] = {0.f, 0.f};
        const LAS float* tb = tab + h * 260;
        const float cfar = tb[256];
        const int jstart = c < 8 ? 8 - c : 0;
        for (int blk = jstart * 2; blk < 18; ++blk) {
            const int j = blk >> 1, koff = (j - 8) * 64 + (blk & 1) * 32;
            const int kt = c * 64 + koff;
            bf16x8 kf[4];
#pragma unroll
            for (int d0 = 0; d0 < 4; ++d0) kf[d0] = *(const bf16x8*)(Kb + (size_t)(b * SEQ + kt + r32) * 512 + h * 64 + d0 * 16 + hi * 8);
            bf16x8 vf[2][2];
#pragma unroll
            for (int db = 0; db < 2; ++db)
#pragma unroll
                for (int s = 0; s < 2; ++s) { const bf16* vp = Vt + (((size_t)(bh * 64 + db * 32 + r32)) << 12) + kt + 16 * s + 4 * hi;
                    const v2u lo = *(const v2u*)vp, hv = *(const v2u*)(vp + 8); v4u w; w.x = lo.x; w.y = lo.y; w.z = hv.x; w.w = hv.y; vf[db][s] = __builtin_bit_cast(bf16x8, w); }
            f32x16 sc[2];
            const float init = j < 6 ? cfar : 0.f;
#pragma unroll
            for (int qb = 0; qb < 2; ++qb) {
#pragma unroll
                for (int i = 0; i < 16; ++i) sc[qb][i] = init;
#pragma unroll
                for (int d0 = 0; d0 < 4; ++d0) sc[qb] = __builtin_amdgcn_mfma_f32_32x32x16_bf16(kf[d0], qf[qb][d0], sc[qb], 0, 0, 0);
            }
            if (j >= 6) {
#pragma unroll
                for (int qb = 0; qb < 2; ++qb)
#pragma unroll
                    for (int i = 0; i < 16; ++i) { int dist = (qb * 32 + r32) - (koff + crow(i, hi)); dist = dist < -128 ? -128 : (dist > 128 ? 128 : dist); sc[qb][i] += tb[dist + 128]; }
            }
            bf16x8 pf[2][2];
#pragma unroll
            for (int qb = 0; qb < 2; ++qb) {
                float mx = sc[qb][0];
#pragma unroll
                for (int i = 1; i < 16; ++i) mx = fmaxf(mx, sc[qb][i]);
                mx = fmaxf(mx, __shfl_xor(mx, 32));
                const float mnew = fmaxf(mrow[qb], mx), alpha = __builtin_amdgcn_exp2f(mrow[qb] - mnew);
                mrow[qb] = mnew;
                float ps = 0.f;
#pragma unroll
                for (int i = 0; i < 16; ++i) { const float p = __builtin_amdgcn_exp2f(sc[qb][i] - mnew); sc[qb][i] = p; ps += p; }
                lrow[qb] = lrow[qb] * alpha + ps;
#pragma unroll
                for (int db = 0; db < 2; ++db)
#pragma unroll
                    for (int i = 0; i < 16; ++i) o[db][qb][i] *= alpha;
#pragma unroll
                for (int s = 0; s < 2; ++s) { v4u w;
                    w.x = cvt_pk_bf16(sc[qb][8 * s + 0], sc[qb][8 * s + 1]); w.y = cvt_pk_bf16(sc[qb][8 * s + 2], sc[qb][8 * s + 3]);
                    w.z = cvt_pk_bf16(sc[qb][8 * s + 4], sc[qb][8 * s + 5]); w.w = cvt_pk_bf16(sc[qb][8 * s + 6], sc[qb][8 * s + 7]);
                    pf[qb][s] = __builtin_bit_cast(bf16x8, w); }
            }
#pragma unroll
            for (int db = 0; db < 2; ++db)
#pragma unroll
                for (int qb = 0; qb < 2; ++qb)
#pragma unroll
                    for (int s = 0; s < 2; ++s) o[db][qb] = __builtin_amdgcn_mfma_f32_32x32x16_bf16(vf[db][s], pf[qb][s], o[db][qb], 0, 0, 0);
        }
#pragma unroll
        for (int qb = 0; qb < 2; ++qb) {
            const float l = lrow[qb] + __shfl_xor(lrow[qb], 32), inv = 1.0f / l;
            const size_t tok = (size_t)(tok0 + qb * 32 + r32);
#pragma unroll
            for (int db = 0; db < 2; ++db)
#pragma unroll
                for (int g4 = 0; g4 < 4; ++g4) { const int d = h * 64 + db * 32 + 8 * g4 + 4 * hi;
                    const v2u g = *(const v2u*)(GA + tok * 512 + d); v2u w;
                    w.x = cvt_pk_bf16(o[db][qb][4 * g4 + 0] * inv * bf_lo(g.x), o[db][qb][4 * g4 + 1] * inv * bf_hi(g.x));
                    w.y = cvt_pk_bf16(o[db][qb][4 * g4 + 2] * inv * bf_lo(g.y), o[db][qb][4 * g4 + 3] * inv * bf_hi(g.y));
                    *(v2u*)(Y + tok * 1024 + d) = w; }
        }
    }
}

constexpr int SGU_PITCH = 264;
__device__ __forceinline__ void sgu_phase(const bf16* UB, const bf16* VB, const bf16* GB, bf16* Y, const float* ln_g, const float* ln_b, const bf16* Wsb, const float* b_s,
                                          LAS unsigned char* img, int first, int step, int wave, int lane) {
    const int r32 = lane & 31, hi = lane >> 5;
    for (int unit = first; unit < M / 128; unit += step) {
        const int tok0 = unit * 128;
        float gam[8], bet[8];
#pragma unroll
        for (int e = 0; e < 8; ++e) { gam[e] = ln_g[lane + 64 * e]; bet[e] = ln_b[lane + 64 * e]; }
        for (int tt = 0; tt < 8; ++tt) {
            const int s0 = wave * 16 + tt * 2;
            float v0[8], v1[8], a0 = 0.f, a1 = 0.f;
#pragma unroll
            for (int e = 0; e < 8; ++e) { v0[e] = __uint_as_float((unsigned)VB[(size_t)(tok0 + s0) * 512 + lane + 64 * e] << 16); v1[e] = __uint_as_float((unsigned)VB[(size_t)(tok0 + s0 + 1) * 512 + lane + 64 * e] << 16); a0 += v0[e]; a1 += v1[e]; }
            const float mu0 = wave_sum(a0) * (1.0f / 512.0f), mu1 = wave_sum(a1) * (1.0f / 512.0f);
            float q0 = 0.f, q1 = 0.f;
#pragma unroll
            for (int e = 0; e < 8; ++e) { v0[e] -= mu0; v1[e] -= mu1; q0 += v0[e] * v0[e]; q1 += v1[e] * v1[e]; }
            const float r0 = 1.0f / sqrtf(wave_sum(q0) * (1.0f / 512.0f) + EPS), r1 = 1.0f / sqrtf(wave_sum(q1) * (1.0f / 512.0f) + EPS);
#pragma unroll
            for (int e = 0; e < 8; ++e) *(LAS unsigned*)(img + (lane + 64 * e) * SGU_PITCH + s0 * 2) = cvt_pk_bf16(v0[e] * r0 * gam[e] + bet[e], v1[e] * r1 * gam[e] + bet[e]);
        }
        __syncthreads();
        const int g = wave >> 1, ch = wave & 1;
        bf16x8 af[2][8];
#pragma unroll
        for (int cb = 0; cb < 2; ++cb)
#pragma unroll
            for (int kk = 0; kk < 8; ++kk) { const LAS unsigned char* p = img + (g * 128 + ch * 64 + cb * 32 + r32) * SGU_PITCH + kk * 32 + hi * 16;
                const v2u lo = *(const LAS v2u*)p, hv = *(const LAS v2u*)(p + 8); v4u w; w.x = lo.x; w.y = lo.y; w.z = hv.x; w.w = hv.y; af[cb][kk] = __builtin_bit_cast(bf16x8, w); }
#pragma unroll
        for (int tb = 0; tb < 4; ++tb) {
            f32x16 acc[2];
#pragma unroll
            for (int cb = 0; cb < 2; ++cb)
#pragma unroll
                for (int i = 0; i < 16; ++i) acc[cb][i] = 0.f;
            const int t = tb * 32 + r32;
#pragma unroll
            for (int kk = 0; kk < 2 * tb + 2; ++kk) {
                const bf16x8 bfr = *(const bf16x8*)(Wsb + (size_t)(g * 128 + t) * 128 + kk * 16 + hi * 8);
#pragma unroll
                for (int cb = 0; cb < 2; ++cb) acc[cb] = __builtin_amdgcn_mfma_f32_32x32x16_bf16(af[cb][kk], bfr, acc[cb], 0, 0, 0);
            }
            const float bs = b_s[g * 128 + t]; const size_t tok = (size_t)(tok0 + t);
#pragma unroll
            for (int cb = 0; cb < 2; ++cb)
#pragma unroll
                for (int g4 = 0; g4 < 4; ++g4) { const int cc = g * 128 + ch * 64 + cb * 32 + 8 * g4 + 4 * hi;
                    const v2u uu = *(const v2u*)(UB + tok * 512 + cc), gg = *(const v2u*)(GB + tok * 512 + cc); v2u w;
                    w.x = cvt_pk_bf16(bf_lo(uu.x) * (acc[cb][4 * g4 + 0] + bs) * bf_lo(gg.x), bf_hi(uu.x) * (acc[cb][4 * g4 + 1] + bs) * bf_hi(gg.x));
                    w.y = cvt_pk_bf16(bf_lo(uu.y) * (acc[cb][4 * g4 + 2] + bs) * bf_lo(gg.y), bf_hi(uu.y) * (acc[cb][4 * g4 + 3] + bs) * bf_hi(gg.y));
                    *(v2u*)(Y + tok * 1024 + 512 + cc) = w; }
        }
        __syncthreads();
    }
}

__device__ __forceinline__ void final_phase(float* out, const float* rowss, int gw, int NGW, int lane) {
    for (int m = gw; m < M; m += NGW) {
        const f32x4* rp = (const f32x4*)rowss + m;
        const f32x4 a = rp[0], b = rp[M], c = rp[2 * M], d = rp[3 * M];
        const float ss = (((a.x + a.y) + (a.z + a.w)) + ((b.x + b.y) + (b.z + b.w))) + (((c.x + c.y) + (c.z + c.w)) + ((d.x + d.y) + (d.z + d.w)));
        const float r = 1.0f / sqrtf(ss * (1.0f / D) + EPS);
        GAS f32x4* o = (GAS f32x4*)(out + (size_t)m * D) + lane;
#pragma unroll
        for (int j = 0; j < 4; ++j) o[64 * j] = o[64 * j] * r;
    }
}

__global__ void __launch_bounds__(NWAVES * 64, 2) fwd_mega(Args args) {
    extern __shared__ __attribute__((aligned(16))) unsigned char lds_raw[];
    LAS unsigned char* lds = (LAS unsigned char*)lds_raw;
    cg::grid_group grid = cg::this_grid();
    const int tid = threadIdx.x, lane = tid & 63, wave = __builtin_amdgcn_readfirstlane(tid >> 6);
    const int G = gridDim.x, bx = blockIdx.x;
    const int gw = bx * NWAVES + wave, NGW = G * NWAVES;
    unsigned char* ws = args.ws; unsigned char* dout = (unsigned char*)args.out;
    const int lo = args.ph_lo, hi = args.ph_hi;
#ifndef PH_MASK
#define PH_MASK 63
#endif
#define IN(k) (((PH_MASK >> (k)) & 1) && lo <= (k) && (k) < hi)
#define SEAM(k) do { if (IN(k) && IN((k) + 1)) { \
    asm volatile("s_waitcnt vmcnt(0)" ::: "memory"); __syncthreads(); \
    if (tid == 0) { __builtin_amdgcn_fence(__ATOMIC_RELEASE, "agent"); asm volatile("s_waitcnt vmcnt(0)" ::: "memory"); } \
    grid.sync(); \
    if (tid == 0) { __builtin_amdgcn_fence(__ATOMIC_ACQUIRE, "agent"); asm volatile("s_waitcnt vmcnt(0)" ::: "memory"); } \
    __syncthreads(); } } while (0)
#define REPS(k) ((k) == REP_PHASE ? 2 : 1)

    if (IN(0)) { for (int rep = 0; rep < REPS(0); ++rep) p0_prologue(args, lds, gw, NGW, wave, lane); __syncthreads(); }
    SEAM(0);
    if (IN(1)) for (int rep = 0; rep < REPS(1); ++rep) {
        pg8::Gemm g{(const bf16*)(ws + WS_XB), (const bf16*)(ws + WS_WIN), M, DIN, D, D / 64, 0}; pg8::StaticOrder S; S.init(M, DIN, G, bx);
        pg8::EpiIn E{(const float*)(ws + WS_RSTD), args.in[3], ws, dout};
        pg8::gemm_phase<pg8::EpiIn, pg8::StaticOrder, PG8_ALIGN, PG8_SP2>(lds, g, S, E);
    }
    SEAM(1);
    if (IN(2)) for (int rep = 0; rep < REPS(2); ++rep) {
        __syncthreads();
        sgu_phase((const bf16*)(ws + WS_UB), (const bf16*)(ws + WS_VB), (const bf16*)(ws + WS_GB), (bf16*)(ws + WS_Y), args.in[5], args.in[6], (const bf16*)(ws + WS_WSB), args.in[8],
                  lds, bx, G, wave, lane);
        attn_phase((const bf16*)(dout + DO_Q), (const bf16*)(dout + DO_K), (const bf16*)(dout + DO_VT), (const bf16*)(dout + DO_GA), (bf16*)(ws + WS_Y), args.in[4],
                   (LAS float*)lds, gw, NGW, tid, lane);
        __syncthreads();
    }
    SEAM(2);
    if (IN(3)) for (int rep = 0; rep < REPS(3); ++rep) {
        pg8::Gemm g{(const bf16*)(ws + WS_Y), (const bf16*)(ws + WS_WP), M, D, D, 8, 1024}; pg8::SplitKOrder S; S.B.init(M, D, G, bx);
        pg8::EpiMerge E{(const bf16*)(ws + WS_GTA), (const bf16*)(ws + WS_GTB), (bf16*)(ws + WS_MRG)};
        pg8::gemm_phase<pg8::EpiMerge, pg8::SplitKOrder, PG8_ALIGN, PG8_SP2>(lds, g, S, E);
    }
    SEAM(3);
    if (IN(4)) for (int rep = 0; rep < REPS(4); ++rep) {
        pg8::Gemm g{(const bf16*)(ws + WS_MRG), (const bf16*)(ws + WS_WO), M, D, D, D / 64, 0}; pg8::StaticOrder S; S.init(M, D, G, bx);
        pg8::EpiOut E{args.in[0], args.in[12], args.out, (float*)(ws + WS_ROWSS)};
        pg8::gemm_phase<pg8::EpiOut, pg8::StaticOrder, PG8_ALIGN, PG8_SP2>(lds, g, S, E);
    }
    SEAM(4);
    if (IN(5)) final_phase(args.out, (const float*)(ws + WS_ROWSS), gw, NGW, lane);
#undef IN
#undef SEAM
#undef REPS
}

#ifndef MK_N_LAUNCHES
#define MK_N_LAUNCHES 1
#endif
extern "C" void kernel_launch(void* const* d_in, const int* in_sizes, int n_in, void* d_out, int out_size, void* d_ws, size_t ws_size, hipStream_t stream) {
    static int grid = 0;
    if (grid == 0) {
        if (n_in != 13 || in_sizes[0] != M * D || out_size != M * D || ws_size < WS_END) { fprintf(stderr, "kernel_launch: unexpected shapes (n_in %d, in0 %d, out %d, ws %zu); nothing launched\n", n_in, n_in > 0 ? in_sizes[0] : -1, out_size, ws_size); grid = -1; return; }
        int dev = 0, cus = 0, per_cu = 0;
        if (hipGetDevice(&dev) != hipSuccess || hipDeviceGetAttribute(&cus, hipDeviceAttributeMultiprocessorCount, dev) != hipSuccess) { fprintf(stderr, "kernel_launch: device query failed\n"); grid = -1; return; }
        if (hipFuncSetAttribute((const void*)fwd_mega, hipFuncAttributeMaxDynamicSharedMemorySize, LDS_BYTES) != hipSuccess) { fprintf(stderr, "kernel_launch: hipFuncSetAttribute failed\n"); grid = -1; return; }
        if (hipOccupancyMaxActiveBlocksPerMultiprocessor(&per_cu, (const void*)fwd_mega, NWAVES * 64, LDS_BYTES) != hipSuccess || per_cu < 1) { fprintf(stderr, "kernel_launch: occupancy query says %d blocks per CU\n", per_cu); per_cu = 1; }
        (void)hipGetLastError();
        grid = cus * per_cu;
    }
    if (grid < 0) return;
    Args a{};
    for (int i = 0; i < 13; ++i) a.in[i] = (const float*)d_in[i];
    a.out = (float*)d_out; a.ws = (unsigned char*)d_ws;
#if MK_N_LAUNCHES == 1
    a.ph_lo = 0; a.ph_hi = 6;
    void* kargs[] = {&a};
    hipError_t e = hipLaunchCooperativeKernel((const void*)fwd_mega, dim3(grid), dim3(NWAVES * 64), kargs, LDS_BYTES, stream);
    if (e != hipSuccess) fprintf(stderr, "kernel_launch: cooperative launch failed: %s (grid %d)\n", hipGetErrorString(e), grid);
#else
    for (int p = 0; p < 6; ++p) { a.ph_lo = p; a.ph_hi = p + 1; hipLaunchKernelGGL(fwd_mega, dim3(grid), dim3(NWAVES * 64), LDS_BYTES, stream, a); }
#endif
}
```

```cpp
#include <hip/hip_runtime.h>
#include <hip/hip_cooperative_groups.h>
#include <cstdio>
#include <cstdint>
namespace cg = cooperative_groups;
constexpr int NWAVES = 8;
constexpr int BATCH = 8, SEQ = 4096, D = 1024, M = BATCH * SEQ;
constexpr int DA = 512, DB = 512, DIN = 5632, NH = 8, HD = 64, NREL = 257;
constexpr float EPS = 1e-6f;
constexpr size_t MiB = 1u << 20;
constexpr size_t WS_RSTD = 1 * MiB;
constexpr size_t WS_WSB = 1 * MiB + 512 * 1024;
constexpr size_t WS_ROWSS = 2 * MiB;
constexpr size_t WS_WIN = 4 * MiB;
constexpr size_t WS_WP = 16 * MiB;
constexpr size_t WS_WO = 18 * MiB;
constexpr size_t WS_XB = 32 * MiB;
constexpr size_t WS_UB = 96 * MiB, WS_VB = 128 * MiB, WS_GB = 160 * MiB;
constexpr size_t WS_GTA = 192 * MiB, WS_GTB = 256 * MiB;
constexpr size_t WS_Y = 320 * MiB;
constexpr size_t WS_MRG = 384 * MiB;
constexpr size_t WS_END = 448 * MiB;
constexpr size_t DO_Q = 0, DO_K = 32 * MiB, DO_VT = 64 * MiB, DO_GA = 96 * MiB;

namespace pg8 {
#define PG8_LAS __attribute__((address_space(3)))
typedef unsigned short bf16_t;
typedef short bf16x8 __attribute__((ext_vector_type(8)));
typedef float f32x4 __attribute__((ext_vector_type(4)));
typedef unsigned u32x4 __attribute__((ext_vector_type(4)));
constexpr int BM = 256, BK = 64, HALF = 128, HTB = HALF * BK * 2  , STAGE_BYTES = 8 * HTB, NXCD = 8, WGM = 8;

__host__ __device__ __forceinline__ int lds_byte(int r, int c) { const int st = (r >> 4) * 2 + (c >> 5), rr = r & 15, cc = c & 31, ob = rr * 64 + cc * 2; return st * 1024 + (ob ^ (((ob >> 9) & 1) << 5)); }
__host__ __device__ __forceinline__ void stage_rc(int b, int& R, int& C) { const int st = b / 1024, sb = b % 1024, swz = sb ^ (((sb >> 9) & 1) << 5); R = (st >> 1) * 16 + swz / 64; C = (st & 1) * 32 + (swz % 64) / 2; }
__host__ __device__ __forceinline__ int perm32(int rho) { const int n = rho >> 4, i = rho & 15; return 8 * (i >> 2) + 4 * n + (i & 3); }

struct Unit { int pm, pn, kh; };
struct Gemm { const bf16_t* A; const bf16_t* Bt; int M, N, K, nt; size_t khstep; };

struct StaticOrder {
    int nM, nN, nwg, G, c;
    __host__ __device__ void init(int M, int N, int G_, int c_) { nM = M / BM; nN = N / BM; nwg = nM * nN; G = G_; c = c_; }
    __host__ __device__ bool next(int i, Unit& u) const {
        const long L = (long)i * G + c; if (L >= nwg) return false;
        int wgid = (int)L; { const int q = nwg / NXCD, r = nwg % NXCD, xcd = wgid % NXCD, off = wgid / NXCD; wgid = (xcd < r ? xcd * (q + 1) : r * (q + 1) + (xcd - r) * q) + off; }
        const int nig = WGM * nN, gid = wgid / nig, fm = gid * WGM, gsz = (nM - fm) < WGM ? (nM - fm) : WGM;
        u.pm = fm + ((wgid % nig) % gsz); u.pn = (wgid % nig) / gsz; u.kh = 0; return true;
    }
    __device__ __forceinline__ void a_ready(const Unit&) const {}
    __device__ __forceinline__ void done(const Unit&) const {}
};
struct SplitKOrder { StaticOrder B;
    __device__ bool next(int i, Unit& u) const { if (!B.next(i >> 1, u)) return false; u.kh = i & 1; return true; }
    __device__ __forceinline__ void a_ready(const Unit&) const {}
    __device__ __forceinline__ void done(const Unit&) const {}
};
typedef float f32x2_cv __attribute__((ext_vector_type(2))); typedef __bf16 bf16x2_cv __attribute__((ext_vector_type(2)));
__device__ __forceinline__ unsigned cvt_pk_bf16(float lo, float hi) { const f32x2_cv v = {lo, hi}; const bf16x2_cv b = __builtin_convertvector(v, bf16x2_cv); return __builtin_bit_cast(unsigned, b); }
typedef float f32x2 __attribute__((ext_vector_type(2)));

constexpr float LOG2E = 1.4426950408889634f;
constexpr float QSCALE = 0.125f * LOG2E;
__device__ __forceinline__ float sigm(float t) { return __builtin_amdgcn_rcpf(1.0f + __builtin_amdgcn_exp2f(-LOG2E * t)); }
__device__ __forceinline__ float bf_lo(unsigned w) { return __uint_as_float(w << 16); }
__device__ __forceinline__ float bf_hi(unsigned w) { return __uint_as_float(w & 0xffff0000u); }

struct EpiIn {
    static constexpr bool PERM = true, AFTER_DRAIN = false, MID = false;
    const float* rstd; const float* b_gate;
    unsigned char* ws; unsigned char* dout;
    __device__ __forceinline__ void operator()(const f32x4 (&acc)[2][2][4][2], const Unit& u, int wr, int wc, int fr, int fq) const {
        const int pn = u.pn, row0 = u.pm * BM + wr * 64 + fr, lc = wc * 32 + 8 * fq;
        if (pn < 4) {
            bf16_t* base = (bf16_t*)(dout + (pn < 2 ? DO_Q : DO_K)); const float sc = pn < 2 ? QSCALE : 1.0f; const int col0 = (pn & 1) * 256 + lc;
#pragma unroll
            for (int ai = 0; ai < 2; ++ai)
#pragma unroll
                for (int m = 0; m < 4; ++m) { bf16_t* rowp = base + (size_t)(row0 + ai * HALF + m * 16) * 512 + col0; const float s = rstd[row0 + ai * HALF + m * 16] * sc;
#pragma unroll
                    for (int bj = 0; bj < 2; ++bj) { const f32x4 v0 = acc[ai][bj][m][0] * s, v1 = acc[ai][bj][m][1] * s;
                        u32x4 w; w.x = cvt_pk_bf16(v0[0], v0[1]); w.y = cvt_pk_bf16(v0[2], v0[3]); w.z = cvt_pk_bf16(v1[0], v1[1]); w.w = cvt_pk_bf16(v1[2], v1[3]);
                        *(u32x4*)(rowp + bj * HALF) = w; } }
        } else if (pn < 6) {
#pragma unroll
            for (int ai = 0; ai < 2; ++ai)
#pragma unroll
                for (int m = 0; m < 4; ++m) { const int row = row0 + ai * HALF + m * 16, b = row >> 12, t = row & 4095; const float s = rstd[row0 + ai * HALF + m * 16];
#pragma unroll
                    for (int bj = 0; bj < 2; ++bj) { const int c0 = (pn - 4) * 256 + bj * HALF + lc;
                        bf16_t* p = (bf16_t*)(dout + DO_VT) + (((size_t)(b * 512 + c0)) << 12) + t;
#pragma unroll
                        for (int n = 0; n < 2; ++n)
#pragma unroll
                            for (int i = 0; i < 4; i += 2) { const unsigned w = cvt_pk_bf16(acc[ai][bj][m][n][i] * s, acc[ai][bj][m][n][i + 1] * s);
                                p[(size_t)(4 * n + i) << 12] = (bf16_t)(w & 0xffffu); p[(size_t)(4 * n + i + 1) << 12] = (bf16_t)(w >> 16); } } }
        } else if (pn < 14) {
            const int seg = (pn - 6) >> 1; bf16_t* base = (bf16_t*)(seg == 0 ? dout + DO_GA : ws + WS_UB + (size_t)(seg - 1) * (WS_VB - WS_UB));
            const bool gl = (seg == 1 || seg == 2); const float a1 = gl ? 1.5957691216057308f : 1.0f, a3 = gl ? 1.5957691216057308f * 0.044715f : 0.0f;
            const int col0 = (pn & 1) * 256 + lc;
#pragma unroll
            for (int ai = 0; ai < 2; ++ai)
#pragma unroll
                for (int m = 0; m < 4; ++m) { bf16_t* rowp = base + (size_t)(row0 + ai * HALF + m * 16) * 512 + col0; const float s = rstd[row0 + ai * HALF + m * 16];
#pragma unroll
                    for (int bj = 0; bj < 2; ++bj) { float o[8];
#pragma unroll
                        for (int n = 0; n < 2; ++n)
#pragma unroll
                            for (int i = 0; i < 4; ++i) { const float v = acc[ai][bj][m][n][i] * s; o[4 * n + i] = v * sigm(v * (a1 + a3 * v * v)); }
                        u32x4 w; w.x = cvt_pk_bf16(o[0], o[1]); w.y = cvt_pk_bf16(o[2], o[3]); w.z = cvt_pk_bf16(o[4], o[5]); w.w = cvt_pk_bf16(o[6], o[7]);
                        *(u32x4*)(rowp + bj * HALF) = w; } }
        } else {
            bf16_t* base = (bf16_t*)(ws + (pn < 18 ? WS_GTA : WS_GTB)); const int col0 = ((pn - 14) & 3) * 256 + lc, bcol0 = (pn - 14) * 256 + lc;
#pragma unroll
            for (int ai = 0; ai < 2; ++ai)
#pragma unroll
                for (int m = 0; m < 4; ++m) { bf16_t* rowp = base + (size_t)(row0 + ai * HALF + m * 16) * 1024 + col0; const float s = rstd[row0 + ai * HALF + m * 16];
#pragma unroll
                    for (int bj = 0; bj < 2; ++bj) { float o[8];
#pragma unroll
                        for (int n = 0; n < 2; ++n) { const f32x4 bvv = *(const f32x4*)(b_gate + bcol0 + bj * HALF + 4 * n);
#pragma unroll
                            for (int i = 0; i < 4; ++i) o[4 * n + i] = sigm(acc[ai][bj][m][n][i] * s + bvv[i]); }
                        u32x4 w; w.x = cvt_pk_bf16(o[0], o[1]); w.y = cvt_pk_bf16(o[2], o[3]); w.z = cvt_pk_bf16(o[4], o[5]); w.w = cvt_pk_bf16(o[6], o[7]);
                        *(u32x4*)(rowp + bj * HALF) = w; } }
        }
    }
};

struct EpiMerge {
    static constexpr bool PERM = true, AFTER_DRAIN = false, MID = true;
    const bf16_t *GTA, *GTB; bf16_t* O;
    __device__ __forceinline__ void mid(f32x4 (&acc)[2][2][4][2], const Unit& u, int wr, int wc, int fr, int fq) const {
        const int row0 = u.pm * BM + wr * 64 + fr, col0 = u.pn * BM + wc * 32 + 8 * fq;
#pragma unroll
        for (int ai = 0; ai < 2; ++ai)
#pragma unroll
            for (int m = 0; m < 4; ++m) { const size_t off = (size_t)(row0 + ai * HALF + m * 16) * 1024 + col0;
#pragma unroll
                for (int bj = 0; bj < 2; ++bj) { const u32x4 a = *(const u32x4*)(GTA + off + bj * HALF), b = *(const u32x4*)(GTB + off + bj * HALF);
#pragma unroll
                    for (int j = 0; j < 4; ++j) { const float r0 = bf_lo(a[j]) * __builtin_amdgcn_rcpf(bf_lo(b[j])), r1 = bf_hi(a[j]) * __builtin_amdgcn_rcpf(bf_hi(b[j]));
                        acc[ai][bj][m][j >> 1][(j & 1) * 2] *= r0; acc[ai][bj][m][j >> 1][(j & 1) * 2 + 1] *= r1; } }
                asm volatile("" ::: "memory"); }
    }
    __device__ __forceinline__ void operator()(const f32x4 (&acc)[2][2][4][2], const Unit& u, int wr, int wc, int fr, int fq) const {
        const int row0 = u.pm * BM + wr * 64 + fr, col0 = u.pn * BM + wc * 32 + 8 * fq;
#pragma unroll
        for (int ai = 0; ai < 2; ++ai)
#pragma unroll
            for (int m = 0; m < 4; ++m) { const size_t off = (size_t)(row0 + ai * HALF + m * 16) * 1024 + col0;
#pragma unroll
                for (int bj = 0; bj < 2; ++bj) { const u32x4 b = *(const u32x4*)(GTB + off + bj * HALF); u32x4 w;
#pragma unroll
                    for (int j = 0; j < 4; ++j) w[j] = cvt_pk_bf16(acc[ai][bj][m][j >> 1][(j & 1) * 2] * bf_lo(b[j]), acc[ai][bj][m][j >> 1][(j & 1) * 2 + 1] * bf_hi(b[j]));
                    *(u32x4*)(O + off + bj * HALF) = w; } }
    }
};

struct EpiOut {
    static constexpr bool PERM = false, AFTER_DRAIN = false, MID = false;
    const float* x; const float* fg; float* out; float* rowss;
    __device__ __forceinline__ void operator()(const f32x4 (&acc)[2][2][4][2], const Unit& u, int wr, int wc, int fr, int fq) const {
        const int row0 = u.pm * BM + wr * 64 + fr, col0 = u.pn * BM + wc * 32 + 4 * fq;
        f32x4 gv[2][2];
#pragma unroll
        for (int bj = 0; bj < 2; ++bj)
#pragma unroll
            for (int n = 0; n < 2; ++n) gv[bj][n] = *(const f32x4*)(fg + col0 + bj * HALF + n * 16);
#pragma unroll
        for (int ai = 0; ai < 2; ++ai)
#pragma unroll
            for (int m = 0; m < 4; ++m) { const int row = row0 + ai * HALF + m * 16; const size_t off = (size_t)row * 1024 + col0; float ss = 0.f;
#pragma unroll
                for (int bj = 0; bj < 2; ++bj)
#pragma unroll
                    for (int n = 0; n < 2; ++n) { const f32x4 v = acc[ai][bj][m][n] + *(const f32x4*)(x + off + bj * HALF + n * 16);
                        ss += (v[0] * v[0] + v[1] * v[1]) + (v[2] * v[2] + v[3] * v[3]); *(f32x4*)(out + off + bj * HALF + n * 16) = v * gv[bj][n]; }
                ss += __shfl_xor(ss, 16); ss += __shfl_xor(ss, 32);
                if (fq == 0) rowss[((size_t)u.pn * 32768 + row) * 4 + wc] = ss; }
    }
};
template <class Epi, class Sched, bool ALIGN_EPI = false, bool SP2 = false>
__device__ __forceinline__ void gemm_phase(PG8_LAS unsigned char* lds, const Gemm g, const Sched& S, const Epi& E) {
    const int tid = threadIdx.x, wid = __builtin_amdgcn_readfirstlane(tid >> 6), lane = tid & 63, wr = wid >> 2, wc = wid & 3, fr = lane & 15, fq = lane >> 4;
    const int K = g.K, nt = g.nt;
    unsigned voffA[2], voffB[2];
#pragma unroll
    for (int i = 0; i < 2; ++i) { int R, C; stage_rc(tid * 16 + i * 8192, R, C); const int Rb = Epi::PERM ? ((R & ~31) + perm32(R & 31)) : R;
        voffA[i] = (unsigned)(R * K + C) * 2u; voffB[i] = (unsigned)(Rb * K + C) * 2u; }
    const size_t kstep = (size_t)(BK * 2);
    const size_t hstep = (size_t)HALF * K * 2;
    const size_t tstep = 2 * hstep;
    const unsigned ldsw = (unsigned)wid * 1024u;
    const int aoff = lds_byte(wr * 64 + fr, fq * 8), boff = lds_byte(wc * 32 + fr, fq * 8);
#define PG8_SA(b, h) (((b) * 2 + (h)) * HTB)
#define PG8_SB(b, h) ((4 + (b) * 2 + (h)) * HTB)
#define PG8_STAGE(bufoff, gbase, voff) do { _Pragma("unroll") for (int _i = 0; _i < 2; ++_i) \
        __builtin_amdgcn_global_load_lds((const unsigned*)((const char*)(gbase) + (voff)[_i]), (PG8_LAS unsigned*)(lds + (bufoff) + ldsw + _i * 8192), 16, 0, 0); } while (0)
#define PG8_LDA(dst, b, h) do { _Pragma("unroll") for (int m = 0; m < 4; ++m) _Pragma("unroll") for (int k = 0; k < 2; ++k) dst[m][k] = *(const PG8_LAS bf16x8*)(lds + PG8_SA(b, h) + aoff + m * 2048 + k * 1024); } while (0)
#define PG8_LDB(dst, b, h) do { _Pragma("unroll") for (int n = 0; n < 2; ++n) _Pragma("unroll") for (int k = 0; k < 2; ++k) dst[n][k] = *(const PG8_LAS bf16x8*)(lds + PG8_SB(b, h) + boff + n * 2048 + k * 1024); } while (0)
#define PG8_MMA(ai, bj, At, Bt) do { __builtin_amdgcn_s_setprio(1); _Pragma("unroll") for (int m = 0; m < 4; ++m) _Pragma("unroll") for (int n = 0; n < 2; ++n) _Pragma("unroll") for (int k = 0; k < 2; ++k) \
        acc[ai][bj][m][n] = __builtin_amdgcn_mfma_f32_16x16x32_bf16(Bt[n][k], At[m][k], acc[ai][bj][m][n], 0, 0, 0); __builtin_amdgcn_s_setprio(0); } while (0)
#define PG8_WAIT_V(n) asm volatile("s_waitcnt vmcnt(" #n ")" ::: "memory")
#define PG8_WAIT_L(n) asm volatile("s_waitcnt lgkmcnt(" #n ")" ::: "memory")
#define PG8_BAR __builtin_amdgcn_s_barrier()
#define PG8_SCHED __builtin_amdgcn_sched_barrier(0)
    Unit cur, nxt; int ui = 0;
    if (!S.next(0, cur)) return;
    f32x4 acc[2][2][4][2];
#pragma unroll
    for (int a = 0; a < 2; ++a)
#pragma unroll
        for (int b = 0; b < 2; ++b)
#pragma unroll
            for (int m = 0; m < 4; ++m)
#pragma unroll
                for (int n = 0; n < 2; ++n) acc[a][b][m][n] = (f32x4){0.f, 0.f, 0.f, 0.f};
    bf16x8 At[4][2], B0[2][2], B1[2][2];
    const char* cA = (const char*)g.A + (size_t)cur.pm * tstep + (size_t)cur.kh * g.khstep; const char* cB = (const char*)g.Bt + (size_t)cur.pn * tstep + (size_t)cur.kh * g.khstep;
    S.a_ready(cur);
    if constexpr (SP2) {
        PG8_STAGE(PG8_SB(0, 0), cB, voffB); PG8_STAGE(PG8_SB(0, 1), cB + hstep, voffB); PG8_STAGE(PG8_SA(0, 0), cA, voffA); PG8_STAGE(PG8_SA(0, 1), cA + hstep, voffA);
        if (wr == 1) PG8_BAR;
        PG8_WAIT_V(2); PG8_BAR;
        PG8_STAGE(PG8_SB(1, 0), cB + kstep, voffB); PG8_STAGE(PG8_SA(1, 0), cA + kstep, voffA); PG8_STAGE(PG8_SB(1, 1), cB + hstep + kstep, voffB);
        PG8_WAIT_V(6); PG8_BAR;
    } else {
        PG8_STAGE(PG8_SB(0, 0), cB, voffB); PG8_STAGE(PG8_SA(0, 0), cA, voffA); PG8_STAGE(PG8_SB(0, 1), cB + hstep, voffB); PG8_STAGE(PG8_SA(0, 1), cA + hstep, voffA);
        if (wr == 1) PG8_BAR;
        PG8_WAIT_V(4); PG8_BAR;
        PG8_STAGE(PG8_SB(1, 0), cB + kstep, voffB); PG8_STAGE(PG8_SA(1, 0), cA + kstep, voffA); PG8_STAGE(PG8_SB(1, 1), cB + hstep + kstep, voffB);
        PG8_WAIT_V(6); PG8_BAR;
    }
    for (;;) {
        const bool has_next = S.next(ui + 1, nxt);
        const char* nA = has_next ? (const char*)g.A + (size_t)nxt.pm * tstep + (size_t)nxt.kh * g.khstep : cA; const char* nB = has_next ? (const char*)g.Bt + (size_t)nxt.pn * tstep + (size_t)nxt.kh * g.khstep : cB;
        for (int t = 0; t < nt; t += 2) {
            const bool last = (t == nt - 2);
            const char* a1 = cA + (size_t)(t + 1) * kstep;
            const char* a2 = last ? nA : cA + (size_t)(t + 2) * kstep; const char* b2 = last ? nB : cB + (size_t)(t + 2) * kstep;
            const char* a3 = a2 + kstep; const char* b3 = b2 + kstep;
            if (last && has_next) S.a_ready(nxt);
            if constexpr (SP2) {
            PG8_LDB(B0, 0, 0); PG8_LDB(B1, 0, 1); PG8_SCHED; PG8_LDA(At, 0, 0); PG8_STAGE(PG8_SA(1, 1), a1 + hstep, voffA);
            PG8_WAIT_V(8); PG8_WAIT_L(0); PG8_BAR; PG8_MMA(0, 0, At, B0); PG8_MMA(0, 1, At, B1); PG8_BAR; PG8_SCHED;
            PG8_LDA(At, 0, 1); PG8_STAGE(PG8_SB(0, 0), b2, voffB); PG8_STAGE(PG8_SB(0, 1), b2 + hstep, voffB); PG8_STAGE(PG8_SA(0, 0), a2, voffA);
            PG8_WAIT_V(8); PG8_WAIT_L(0); PG8_BAR; PG8_MMA(1, 0, At, B0); PG8_MMA(1, 1, At, B1); PG8_BAR; PG8_SCHED;
            PG8_LDB(B0, 1, 0); PG8_LDB(B1, 1, 1); PG8_SCHED; PG8_LDA(At, 1, 0); PG8_STAGE(PG8_SA(0, 1), a2 + hstep, voffA);
            PG8_WAIT_V(8); PG8_WAIT_L(0); PG8_BAR; PG8_MMA(0, 0, At, B0); PG8_MMA(0, 1, At, B1); PG8_BAR; PG8_SCHED;
            PG8_LDA(At, 1, 1); PG8_STAGE(PG8_SB(1, 0), b3, voffB); PG8_STAGE(PG8_SB(1, 1), b3 + hstep, voffB); PG8_STAGE(PG8_SA(1, 0), a3, voffA);
            PG8_WAIT_V(8); PG8_WAIT_L(0); PG8_BAR; PG8_MMA(1, 0, At, B0); PG8_MMA(1, 1, At, B1); PG8_BAR; PG8_SCHED;
            } else {
            PG8_LDB(B0, 0, 0); PG8_SCHED; PG8_LDA(At, 0, 0); PG8_STAGE(PG8_SA(1, 1), a1 + hstep, voffA);
            PG8_WAIT_L(8); PG8_BAR; PG8_WAIT_L(0); PG8_MMA(0, 0, At, B0); PG8_BAR; PG8_SCHED;
            PG8_LDB(B1, 0, 1); PG8_STAGE(PG8_SB(0, 0), b2, voffB);
            PG8_BAR; PG8_WAIT_L(0); PG8_MMA(0, 1, At, B1); PG8_BAR;
            PG8_LDA(At, 0, 1); PG8_STAGE(PG8_SA(0, 0), a2, voffA);
            PG8_BAR; PG8_WAIT_L(0); PG8_MMA(1, 0, At, B0); PG8_BAR; PG8_SCHED;
            PG8_STAGE(PG8_SB(0, 1), b2 + hstep, voffB);
            PG8_WAIT_V(6); PG8_BAR; PG8_MMA(1, 1, At, B1); PG8_BAR;
            PG8_LDB(B0, 1, 0); PG8_SCHED; PG8_LDA(At, 1, 0); PG8_STAGE(PG8_SA(0, 1), a2 + hstep, voffA);
            PG8_WAIT_L(8); PG8_BAR; PG8_WAIT_L(0); PG8_MMA(0, 0, At, B0); PG8_BAR; PG8_SCHED;
            PG8_LDB(B1, 1, 1); PG8_STAGE(PG8_SB(1, 0), b3, voffB);
            PG8_BAR; PG8_WAIT_L(0); PG8_MMA(0, 1, At, B1); PG8_BAR;
            PG8_LDA(At, 1, 1); PG8_STAGE(PG8_SA(1, 0), a3, voffA);
            PG8_BAR; PG8_WAIT_L(0); PG8_MMA(1, 0, At, B0); PG8_BAR; PG8_SCHED;
            PG8_STAGE(PG8_SB(1, 1), b3 + hstep, voffB);
            PG8_WAIT_V(6); PG8_BAR; PG8_MMA(1, 1, At, B1); PG8_BAR;
            }
        }
        if constexpr (ALIGN_EPI) { if (wr == 0) PG8_BAR; }
        bool keep = false;
        if constexpr (Epi::MID) { if (cur.kh == 0) { E.mid(acc, cur, wr, wc, fr, fq); keep = true; } else E(acc, cur, wr, wc, fr, fq); }
        else if constexpr (!Epi::AFTER_DRAIN) { E(acc, cur, wr, wc, fr, fq); S.done(cur); }
        if (!has_next) break;
        if (!keep)
#pragma unroll
        for (int a = 0; a < 2; ++a)
#pragma unroll
            for (int b = 0; b < 2; ++b)
#pragma unroll
                for (int m = 0; m < 4; ++m)
#pragma unroll
                    for (int n = 0; n < 2; ++n) acc[a][b][m][n] = (f32x4){0.f, 0.f, 0.f, 0.f};
        cur = nxt; cA = nA; cB = nB; ++ui;
        if constexpr (ALIGN_EPI) { if (wr == 1) PG8_BAR; }
    }
    PG8_WAIT_V(0);
    if constexpr (!ALIGN_EPI) { if (wr == 0) PG8_BAR; }
    PG8_BAR;
    if constexpr (Epi::AFTER_DRAIN) { E.fused(acc, cur, wr, wc, fr, fq, lds, wid, lane); S.done(cur); }
#undef PG8_SA
#undef PG8_SB
#undef PG8_STAGE
#undef PG8_LDA
#undef PG8_LDB
#undef PG8_MMA
#undef PG8_WAIT_V
#undef PG8_WAIT_L
#undef PG8_BAR
#undef PG8_SCHED
}
}

#ifndef PG8_SP2
#define PG8_SP2 true
#endif
#ifndef PG8_ALIGN
#define PG8_ALIGN true
#endif
#ifndef REP_PHASE
#define REP_PHASE (-1)
#endif

constexpr int LDS_BYTES = 147456;

#define GAS __attribute__((address_space(1)))
#define LAS __attribute__((address_space(3)))
typedef unsigned short bf16;
typedef unsigned v4u __attribute__((ext_vector_type(4)));
typedef unsigned v2u __attribute__((ext_vector_type(2)));
typedef float f32x4 __attribute__((ext_vector_type(4)));
typedef float f32x16 __attribute__((ext_vector_type(16)));
typedef short bf16x8 __attribute__((ext_vector_type(8)));
using pg8::cvt_pk_bf16; using pg8::bf_lo; using pg8::bf_hi; using pg8::LOG2E;
#define LDS_WAIT() asm volatile("s_waitcnt lgkmcnt(0)" ::: "memory")
__device__ __forceinline__ unsigned f2bf(float f) { unsigned u = __builtin_bit_cast(unsigned, f); return (u + 0x7fffu + ((u >> 16) & 1u)) >> 16; }
__device__ __forceinline__ unsigned pk2(float lo, float hi) { return f2bf(lo) | (f2bf(hi) << 16); }
__device__ __forceinline__ float wave_sum(float v) {
#pragma unroll
    for (int o = 1; o < 64; o <<= 1) v += __shfl_xor(v, o);
    return v;
}
__device__ __forceinline__ int crow(int r, int hi) { return (r & 3) + 8 * (r >> 2) + 4 * hi; }

#define XB_TMO      128
#define XB_XCNT(j)  (256  + 64 * (j))
#define XB_XSUB(j)  (1280 + 64 * (j))
#define XB_XGEN(j)  (2304 + 64 * (j))
#define XB_TOP      3328
#define XB_TOPGEN   3392
#define XCD_BAR_WORDS 3456
#define XB_SPIN_CAP (1u << 18)

__device__ __forceinline__ unsigned xb_ld(unsigned* p)              { return __hip_atomic_load(p, __ATOMIC_RELAXED, __HIP_MEMORY_SCOPE_AGENT); }
__device__ __forceinline__ unsigned xb_add(unsigned* p, unsigned v) { return __hip_atomic_fetch_add(p, v, __ATOMIC_RELAXED, __HIP_MEMORY_SCOPE_AGENT); }
__device__ __forceinline__ unsigned xb_xcc_id() { return (unsigned)__builtin_amdgcn_s_getreg((3 << 11) | 20) & 0xFu; }
#define XB_SPIN(cond, bar) do { unsigned _sp = 0; while (cond) { __builtin_amdgcn_s_sleep(1); \
    if ((++_sp & 255u) == 0u) { if (xb_ld(&(bar)[XB_TMO])) break; if (_sp > XB_SPIN_CAP) { atomicAdd(&(bar)[XB_TMO], 1u); break; } } } } while (0)

struct XcdBarrier {
    unsigned* bar; unsigned x;
    volatile LAS unsigned* st;
};

__device__ __forceinline__ XcdBarrier xcd_barrier_post(unsigned* bar, volatile LAS unsigned* st) {
    XcdBarrier b; b.bar = bar; b.x = xb_xcc_id(); b.st = st;
    if (threadIdx.x == 0) (void)xb_add(&bar[XB_XCNT(b.x)], 1u);
    return b;
}
__device__ __forceinline__ void xcd_barrier_complete(unsigned* bar, unsigned x, unsigned& nloc, unsigned& nx) {
    const unsigned G = gridDim.x * gridDim.y * gridDim.z;
    unsigned sum, cnt, mine, sp = 0u;
    for (;;) {
        sum = 0u; cnt = 0u; mine = 0u;
#pragma unroll
        for (unsigned j = 0; j < 16; ++j) { const unsigned c = xb_ld(&bar[XB_XCNT(j)]); sum += c; cnt += (c > 0u) ? 1u : 0u; mine = (j == x) ? c : mine; }
        if (sum == G) break;
        __builtin_amdgcn_s_sleep(1);
        if ((++sp & 255u) == 0u) { if (xb_ld(&bar[XB_TMO])) break; if (sp > XB_SPIN_CAP) { atomicAdd(&bar[XB_TMO], 1u); break; } }
    }
    nloc = mine > 0u ? mine : 1u; nx = cnt > 0u ? cnt : 1u;
}

__device__ __forceinline__ void xcd_barrier(const XcdBarrier& b) {
    asm volatile("s_waitcnt vmcnt(0)" ::: "memory");
    __syncthreads();
    if (threadIdx.x == 0) {
        unsigned* bar = b.bar;
        __builtin_amdgcn_s_waitcnt(0);
        unsigned nloc = b.st[0], nx = b.st[1];
        if (nloc == 0u) { xcd_barrier_complete(bar, b.x, nloc, nx); b.st[0] = nloc; b.st[1] = nx; }
        const unsigned old = xb_add(&bar[XB_XSUB(b.x)], 1u);
        const unsigned gen = old / nloc;
        if (old + 1u == (gen + 1u) * nloc) {
            __builtin_amdgcn_fence(__ATOMIC_RELEASE, "agent");
            asm volatile("s_waitcnt vmcnt(0)" ::: "memory");
            const unsigned og = xb_add(&bar[XB_TOP], 1u);
            const unsigned tg = og / nx;
            if (og + 1u == (tg + 1u) * nx) xb_add(&bar[XB_TOPGEN], 1u);
            else XB_SPIN(xb_ld(&bar[XB_TOPGEN]) == tg, bar);
            __builtin_amdgcn_fence(__ATOMIC_ACQUIRE, "agent");
            xb_add(&bar[XB_XGEN(b.x)], 1u);
            asm volatile("s_waitcnt vmcnt(0)" ::: "memory");
        } else {
            XB_SPIN(xb_ld(&bar[XB_XGEN(b.x)]) == gen, bar);
            __builtin_amdgcn_fence(__ATOMIC_ACQUIRE, "agent");
            asm volatile("s_waitcnt vmcnt(0)" ::: "memory");
        }
    }
    __syncthreads();
}

struct Args { const float* in[13]; float* out; unsigned char* ws; int ph_lo, ph_hi; };

__device__ __forceinline__ void p0_transpose_item(const float* W, int N, bf16* WT, int ldo, int koff, const float* scale, LAS float* scr, int item, int lane) {
    const int nblk = N / 32, kb = item / nblk, nb = item % nblk, k0 = 64 * kb, n0 = 32 * nb;
#pragma unroll 8
    for (int i = 0; i < 32; ++i) { const int kk = 2 * i + (lane >> 5); const float sc = scale ? scale[k0 + kk] : 1.0f; scr[kk * 33 + (lane & 31)] = W[(size_t)(k0 + kk) * N + n0 + (lane & 31)] * sc; }
    LDS_WAIT(); asm volatile("" ::: "memory");
    const int c = lane & 7;
#pragma unroll
    for (int j = 0; j < 4; ++j) { const int n = (lane >> 3) + 8 * j; const LAS float* s = scr + (8 * c) * 33 + n;
        v4u o; o.x = pk2(s[0 * 33], s[1 * 33]); o.y = pk2(s[2 * 33], s[3 * 33]); o.z = pk2(s[4 * 33], s[5 * 33]); o.w = pk2(s[6 * 33], s[7 * 33]);
        *(GAS v4u*)(WT + (size_t)(n0 + n) * ldo + koff + k0 + 8 * c) = o; }
    LDS_WAIT(); asm volatile("" ::: "memory");
}
__device__ __forceinline__ void p0_prologue(const Args& a, LAS unsigned char* lds, int gw, int NGW, int wave, int lane) {
    unsigned char* ws = a.ws;
    LAS float* scr = (LAS float*)(lds + wave * 16384);
    constexpr int I_IN = (D / 64) * (DIN / 32), I_P = (512 / 64) * (D / 32), I_O = (D / 64) * (D / 32);
    constexpr int NITEMS = I_IN + 2 * I_P + I_O;
    for (int it = gw; it < NITEMS; it += NGW) {
        int r = it;
        if (r < I_IN) { p0_transpose_item(a.in[2], DIN, (bf16*)(ws + WS_WIN), D, 0, a.in[1], scr, r, lane); continue; } r -= I_IN;
        if (r < I_P) { p0_transpose_item(a.in[9], D, (bf16*)(ws + WS_WP), D, 0, nullptr, scr, r, lane); continue; } r -= I_P;
        if (r < I_P) { p0_transpose_item(a.in[10], D, (bf16*)(ws + WS_WP), D, 512, nullptr, scr, r, lane); continue; } r -= I_P;
        p0_transpose_item(a.in[11], D, (bf16*)(ws + WS_WO), D, 0, nullptr, scr, r, lane);
    }
    { const float* w = a.in[7]; bf16* o = (bf16*)(ws + WS_WSB);
      for (int i = gw * 64 + lane; i < 4 * 128 * 128; i += NGW * 64) { const int t = (i >> 7) & 127, s = i & 127; o[i] = (bf16)f2bf(s <= t ? w[i] : 0.0f); } }
    const float* x = a.in[0]; bf16* xb = (bf16*)(ws + WS_XB); float* rstd = (float*)(ws + WS_RSTD);
    const int rows_per = (M + NGW - 1) / NGW;
    for (int m = gw * rows_per; m < M && m < (gw + 1) * rows_per; ++m) {
        const GAS f32x4* xr = (const GAS f32x4*)(x + (size_t)m * D) + lane;
        f32x4 v[4]; float s = 0.f;
#pragma unroll
        for (int j = 0; j < 4; ++j) { v[j] = xr[64 * j]; s += (v[j].x * v[j].x + v[j].y * v[j].y) + (v[j].z * v[j].z + v[j].w * v[j].w); }
        s = wave_sum(s);
        if (lane == 0) rstd[m] = 1.0f / sqrtf(s * (1.0f / D) + EPS);
        GAS unsigned long long* o8 = (GAS unsigned long long*)(xb + (size_t)m * D) + lane;
#pragma unroll
        for (int j = 0; j < 4; ++j) o8[64 * j] = (unsigned long long)pk2(v[j].x, v[j].y) | ((unsigned long long)pk2(v[j].z, v[j].w) << 32);
    }
}

__device__ __forceinline__ void attn_phase(const bf16* Q, const bf16* Kb, const bf16* Vt, const bf16* GA, bf16* Y, const float* rel_bias, LAS float* tab, int gw, int NGW, int tid, int lane) {
    for (int i = tid; i < NH * NREL; i += NWAVES * 64) { const int h = i / NREL, j = i - h * NREL; tab[h * 260 + j] = rel_bias[i] * LOG2E; }
    __syncthreads();
    const int r32 = lane & 31, hi = lane >> 5;
    for (int item = gw; item < BATCH * NH * 64; item += NGW) {
        const int bh = item >> 6, c = item & 63, b = bh >> 3, h = bh & 7;
        const int tok0 = b * SEQ + c * 64;
        bf16x8 qf[2][4];
#pragma unroll
        for (int qb = 0; qb < 2; ++qb)
#pragma unroll
            for (int d0 = 0; d0 < 4; ++d0) qf[qb][d0] = *(const bf16x8*)(Q + (size_t)(tok0 + qb * 32 + r32) * 512 + h * 64 + d0 * 16 + hi * 8);
        f32x16 o[2][2];
#pragma unroll
        for (int x = 0; x < 2; ++x)
#pragma unroll
            for (int y = 0; y < 2; ++y)
#pragma unroll
                for (int i = 0; i < 16; ++i) o[x][y][i] = 0.f;
        float mrow[2] = {-1e30f, -1e30f}, lrow[2] = {0.f, 0.f};
        const LAS float* tb = tab + h * 260;
        const float cfar = tb[256];
        const int jstart = c < 8 ? 8 - c : 0;
        for (int blk = jstart * 2; blk < 18; ++blk) {
            const int j = blk >> 1, koff = (j - 8) * 64 + (blk & 1) * 32;
            const int kt = c * 64 + koff;
            bf16x8 kf[4];
#pragma unroll
            for (int d0 = 0; d0 < 4; ++d0) kf[d0] = *(const bf16x8*)(Kb + (size_t)(b * SEQ + kt + r32) * 512 + h * 64 + d0 * 16 + hi * 8);
            bf16x8 vf[2][2];
#pragma unroll
            for (int db = 0; db < 2; ++db)
#pragma unroll
                for (int s = 0; s < 2; ++s) { const bf16* vp = Vt + (((size_t)(bh * 64 + db * 32 + r32)) << 12) + kt + 16 * s + 4 * hi;
                    const v2u lo = *(const v2u*)vp, hv = *(const v2u*)(vp + 8); v4u w; w.x = lo.x; w.y = lo.y; w.z = hv.x; w.w = hv.y; vf[db][s] = __builtin_bit_cast(bf16x8, w); }
            f32x16 sc[2];
            const float init = j < 6 ? cfar : 0.f;
#pragma unroll
            for (int qb = 0; qb < 2; ++qb) {
#pragma unroll
                for (int i = 0; i < 16; ++i) sc[qb][i] = init;
#pragma unroll
                for (int d0 = 0; d0 < 4; ++d0) sc[qb] = __builtin_amdgcn_mfma_f32_32x32x16_bf16(kf[d0], qf[qb][d0], sc[qb], 0, 0, 0);
            }
            if (j >= 6) {
#pragma unroll
                for (int qb = 0; qb < 2; ++qb)
#pragma unroll
                    for (int i = 0; i < 16; ++i) { int dist = (qb * 32 + r32) - (koff + crow(i, hi)); dist = dist < -128 ? -128 : (dist > 128 ? 128 : dist); sc[qb][i] += tb[dist + 128]; }
            }
            bf16x8 pf[2][2];
#pragma unroll
            for (int qb = 0; qb < 2; ++qb) {
                float mx = sc[qb][0];
#pragma unroll
                for (int i = 1; i < 16; ++i) mx = fmaxf(mx, sc[qb][i]);
                mx = fmaxf(mx, __shfl_xor(mx, 32));
                const float mnew = fmaxf(mrow[qb], mx), alpha = __builtin_amdgcn_exp2f(mrow[qb] - mnew);
                mrow[qb] = mnew;
                float ps = 0.f;
#pragma unroll
                for (int i = 0; i < 16; ++i) { const float p = __builtin_amdgcn_exp2f(sc[qb][i] - mnew); sc[qb][i] = p; ps += p; }
                lrow[qb] = lrow[qb] * alpha + ps;
#pragma unroll
                for (int db = 0; db < 2; ++db)
#pragma unroll
                    for (int i = 0; i < 16; ++i) o[db][qb][i] *= alpha;
#pragma unroll
                for (int s = 0; s < 2; ++s) { v4u w;
                    w.x = cvt_pk_bf16(sc[qb][8 * s + 0], sc[qb][8 * s + 1]); w.y = cvt_pk_bf16(sc[qb][8 * s + 2], sc[qb][8 * s + 3]);
                    w.z = cvt_pk_bf16(sc[qb][8 * s + 4], sc[qb][8 * s + 5]); w.w = cvt_pk_bf16(sc[qb][8 * s + 6], sc[qb][8 * s + 7]);
                    pf[qb][s] = __builtin_bit_cast(bf16x8, w); }
            }
#pragma unroll
            for (int db = 0; db < 2; ++db)
#pragma unroll
                for (int qb = 0; qb < 2; ++qb)
#pragma unroll
                    for (int s = 0; s < 2; ++s) o[db][qb] = __builtin_amdgcn_mfma_f32_32x32x16_bf16(vf[db][s], pf[qb][s], o[db][qb], 0, 0, 0);
        }
#pragma unroll
        for (int qb = 0; qb < 2; ++qb) {
            const float l = lrow[qb] + __shfl_xor(lrow[qb], 32), inv = 1.0f / l;
            const size_t tok = (size_t)(tok0 + qb * 32 + r32);
#pragma unroll
            for (int db = 0; db < 2; ++db)
#pragma unroll
                for (int g4 = 0; g4 < 4; ++g4) { const int d = h * 64 + db * 32 + 8 * g4 + 4 * hi;
                    const v2u g = *(const v2u*)(GA + tok * 512 + d); v2u w;
                    w.x = cvt_pk_bf16(o[db][qb][4 * g4 + 0] * inv * bf_lo(g.x), o[db][qb][4 * g4 + 1] * inv * bf_hi(g.x));
                    w.y = cvt_pk_bf16(o[db][qb][4 * g4 + 2] * inv * bf_lo(g.y), o[db][qb][4 * g4 + 3] * inv * bf_hi(g.y));
                    *(v2u*)(Y + tok * 1024 + d) = w; }
        }
    }
}

constexpr int SGU_PITCH = 264;
__device__ __forceinline__ void sgu_phase(const bf16* UB, const bf16* VB, const bf16* GB, bf16* Y, const float* ln_g, const float* ln_b, const bf16* Wsb, const float* b_s,
                                          LAS unsigned char* img, int first, int step, int wave, int lane) {
    const int r32 = lane & 31, hi = lane >> 5;
    for (int unit = first; unit < M / 128; unit += step) {
        const int tok0 = unit * 128;
        float gam[8], bet[8];
#pragma unroll
        for (int e = 0; e < 8; ++e) { gam[e] = ln_g[lane + 64 * e]; bet[e] = ln_b[lane + 64 * e]; }
        for (int tt = 0; tt < 8; ++tt) {
            const int s0 = wave * 16 + tt * 2;
            float v0[8], v1[8], a0 = 0.f, a1 = 0.f;
#pragma unroll
            for (int e = 0; e < 8; ++e) { v0[e] = __uint_as_float((unsigned)VB[(size_t)(tok0 + s0) * 512 + lane + 64 * e] << 16); v1[e] = __uint_as_float((unsigned)VB[(size_t)(tok0 + s0 + 1) * 512 + lane + 64 * e] << 16); a0 += v0[e]; a1 += v1[e]; }
            const float mu0 = wave_sum(a0) * (1.0f / 512.0f), mu1 = wave_sum(a1) * (1.0f / 512.0f);
            float q0 = 0.f, q1 = 0.f;
#pragma unroll
            for (int e = 0; e < 8; ++e) { v0[e] -= mu0; v1[e] -= mu1; q0 += v0[e] * v0[e]; q1 += v1[e] * v1[e]; }
            const float r0 = 1.0f / sqrtf(wave_sum(q0) * (1.0f / 512.0f) + EPS), r1 = 1.0f / sqrtf(wave_sum(q1) * (1.0f / 512.0f) + EPS);
#pragma unroll
            for (int e = 0; e < 8; ++e) *(LAS unsigned*)(img + (lane + 64 * e) * SGU_PITCH + s0 * 2) = cvt_pk_bf16(v0[e] * r0 * gam[e] + bet[e], v1[e] * r1 * gam[e] + bet[e]);
        }
        __syncthreads();
        const int g = wave >> 1, ch = wave & 1;
        bf16x8 af[2][8];
#pragma unroll
        for (int cb = 0; cb < 2; ++cb)
#pragma unroll
            for (int kk = 0; kk < 8; ++kk) { const LAS unsigned char* p = img + (g * 128 + ch * 64 + cb * 32 + r32) * SGU_PITCH + kk * 32 + hi * 16;
                const v2u lo = *(const LAS v2u*)p, hv = *(const LAS v2u*)(p + 8); v4u w; w.x = lo.x; w.y = lo.y; w.z = hv.x; w.w = hv.y; af[cb][kk] = __builtin_bit_cast(bf16x8, w); }
#pragma unroll
        for (int tb = 0; tb < 4; ++tb) {
            f32x16 acc[2];
#pragma unroll
            for (int cb = 0; cb < 2; ++cb)
#pragma unroll
                for (int i = 0; i < 16; ++i) acc[cb][i] = 0.f;
            const int t = tb * 32 + r32;
#pragma unroll
            for (int kk = 0; kk < 2 * tb + 2; ++kk) {
                const bf16x8 bfr = *(const bf16x8*)(Wsb + (size_t)(g * 128 + t) * 128 + kk * 16 + hi * 8);
#pragma unroll
                for (int cb = 0; cb < 2; ++cb) acc[cb] = __builtin_amdgcn_mfma_f32_32x32x16_bf16(af[cb][kk], bfr, acc[cb], 0, 0, 0);
            }
            const float bs = b_s[g * 128 + t]; const size_t tok = (size_t)(tok0 + t);
#pragma unroll
            for (int cb = 0; cb < 2; ++cb)
#pragma unroll
                for (int g4 = 0; g4 < 4; ++g4) { const int cc = g * 128 + ch * 64 + cb * 32 + 8 * g4 + 4 * hi;
                    const v2u uu = *(const v2u*)(UB + tok * 512 + cc), gg = *(const v2u*)(GB + tok * 512 + cc); v2u w;
                    w.x = cvt_pk_bf16(bf_lo(uu.x) * (acc[cb][4 * g4 + 0] + bs) * bf_lo(gg.x), bf_hi(uu.x) * (acc[cb][4 * g4 + 1] + bs) * bf_hi(gg.x));
                    w.y = cvt_pk_bf16(bf_lo(uu.y) * (acc[cb][4 * g4 + 2] + bs) * bf_lo(gg.y), bf_hi(uu.y) * (acc[cb][4 * g4 + 3] + bs) * bf_hi(gg.y));
                    *(v2u*)(Y + tok * 1024 + 512 + cc) = w; }
        }
        __syncthreads();
    }
}

__device__ __forceinline__ void final_phase(float* out, const float* rowss, int gw, int NGW, int lane) {
    for (int m = gw; m < M; m += NGW) {
        const f32x4* rp = (const f32x4*)rowss + m;
        const f32x4 a = rp[0], b = rp[M], c = rp[2 * M], d = rp[3 * M];
        const float ss = (((a.x + a.y) + (a.z + a.w)) + ((b.x + b.y) + (b.z + b.w))) + (((c.x + c.y) + (c.z + c.w)) + ((d.x + d.y) + (d.z + d.w)));
        const float r = 1.0f / sqrtf(ss * (1.0f / D) + EPS);
        GAS f32x4* o = (GAS f32x4*)(out + (size_t)m * D) + lane;
#pragma unroll
        for (int j = 0; j < 4; ++j) o[64 * j] = o[64 * j] * r;
    }
}

__device__ __forceinline__ void ph1(unsigned char* ws, unsigned char* dout, const float* b_gate, LAS unsigned char* lds, int G, int bx) {
    pg8::Gemm g{(const bf16*)(ws + WS_XB), (const bf16*)(ws + WS_WIN), M, DIN, D, D / 64, 0}; pg8::StaticOrder S; S.init(M, DIN, G, bx);
    pg8::EpiIn E{(const float*)(ws + WS_RSTD), b_gate, ws, dout};
    pg8::gemm_phase<pg8::EpiIn, pg8::StaticOrder, PG8_ALIGN, PG8_SP2>(lds, g, S, E);
}
__device__ __forceinline__ void ph2(const Args& args, unsigned char* ws, unsigned char* dout, LAS unsigned char* lds, int G, int bx, int gw, int NGW, int tid, int wave, int lane) {
    __syncthreads();
    sgu_phase((const bf16*)(ws + WS_UB), (const bf16*)(ws + WS_VB), (const bf16*)(ws + WS_GB), (bf16*)(ws + WS_Y), args.in[5], args.in[6], (const bf16*)(ws + WS_WSB), args.in[8],
              lds, bx, G, wave, lane);
    attn_phase((const bf16*)(dout + DO_Q), (const bf16*)(dout + DO_K), (const bf16*)(dout + DO_VT), (const bf16*)(dout + DO_GA), (bf16*)(ws + WS_Y), args.in[4],
               (LAS float*)lds, gw, NGW, tid, lane);
    __syncthreads();
}
__device__ __forceinline__ void ph3(unsigned char* ws, LAS unsigned char* lds, int G, int bx) {
    pg8::Gemm g{(const bf16*)(ws + WS_Y), (const bf16*)(ws + WS_WP), M, D, D, 8, 1024}; pg8::SplitKOrder S; S.B.init(M, D, G, bx);
    pg8::EpiMerge E{(const bf16*)(ws + WS_GTA), (const bf16*)(ws + WS_GTB), (bf16*)(ws + WS_MRG)};
    pg8::gemm_phase<pg8::EpiMerge, pg8::SplitKOrder, PG8_ALIGN, PG8_SP2>(lds, g, S, E);
}
__device__ __forceinline__ void ph4(const Args& args, unsigned char* ws, LAS unsigned char* lds, int G, int bx) {
    pg8::Gemm g{(const bf16*)(ws + WS_MRG), (const bf16*)(ws + WS_WO), M, D, D, D / 64, 0}; pg8::StaticOrder S; S.init(M, D, G, bx);
    pg8::EpiOut E{args.in[0], args.in[12], args.out, (float*)(ws + WS_ROWSS)};
    pg8::gemm_phase<pg8::EpiOut, pg8::StaticOrder, PG8_ALIGN, PG8_SP2>(lds, g, S, E);
}

__global__ void __launch_bounds__(NWAVES * 64, 2) fwd_mega(Args args) {
    extern __shared__ __attribute__((aligned(16))) unsigned char lds_raw[];
    LAS unsigned char* lds = (LAS unsigned char*)lds_raw;
    cg::grid_group grid = cg::this_grid();
    const int tid = threadIdx.x, lane = tid & 63, wave = __builtin_amdgcn_readfirstlane(tid >> 6);
    const int G = gridDim.x, bx = blockIdx.x;
    const int gw = bx * NWAVES + wave, NGW = G * NWAVES;
    unsigned char* ws = args.ws; unsigned char* dout = (unsigned char*)args.out;
    const int lo = args.ph_lo, hi = args.ph_hi;
    volatile LAS unsigned* bst = (volatile LAS unsigned*)(lds + LDS_BYTES - 64);
    if (tid < 2) bst[tid] = 0u;
    __syncthreads();
    XcdBarrier bar; bar.bar = (unsigned*)ws; bar.x = 0; bar.st = nullptr;
    if (hi - lo > 1) bar = xcd_barrier_post((unsigned*)ws, bst);
#ifndef PH_MASK
#define PH_MASK 63
#endif
#define IN(k) (((PH_MASK >> (k)) & 1) && lo <= (k) && (k) < hi)
#define SEAM(k) do { if (IN(k) && IN((k) + 1)) { if ((k) == 0) { \
    asm volatile("s_waitcnt vmcnt(0)" ::: "memory"); __syncthreads(); \
    if (tid == 0) { __builtin_amdgcn_fence(__ATOMIC_RELEASE, "agent"); asm volatile("s_waitcnt vmcnt(0)" ::: "memory"); } \
    grid.sync(); \
    if (tid == 0) { __builtin_amdgcn_fence(__ATOMIC_ACQUIRE, "agent"); asm volatile("s_waitcnt vmcnt(0)" ::: "memory"); } \
    __syncthreads(); } else xcd_barrier(bar); } } while (0)
#define REPS(k) ((k) == REP_PHASE)

    if (IN(0)) { p0_prologue(args, lds, gw, NGW, wave, lane); if (REPS(0)) p0_prologue(args, lds, gw, NGW, wave, lane); __syncthreads(); }
    SEAM(0);
    if (IN(1)) { ph1(ws, dout, args.in[3], lds, G, bx); if (REPS(1)) ph1(ws, dout, args.in[3], lds, G, bx); }
    SEAM(1);
    if (IN(2)) { ph2(args, ws, dout, lds, G, bx, gw, NGW, tid, wave, lane); if (REPS(2)) ph2(args, ws, dout, lds, G, bx, gw, NGW, tid, wave, lane); }
    SEAM(2);
    if (IN(3)) { ph3(ws, lds, G, bx); if (REPS(3)) ph3(ws, lds, G, bx); }
    SEAM(3);
    if (IN(4)) { ph4(args, ws, lds, G, bx); if (REPS(4)) ph4(args, ws, lds, G, bx); }
    SEAM(4);
    if (IN(5)) final_phase(args.out, (const float*)(ws + WS_ROWSS), gw, NGW, lane);
#undef IN
#undef SEAM
#undef REPS
}

#ifndef MK_N_LAUNCHES
#define MK_N_LAUNCHES 1
#endif
extern "C" void kernel_launch(void* const* d_in, const int* in_sizes, int n_in, void* d_out, int out_size, void* d_ws, size_t ws_size, hipStream_t stream) {
    static int grid = 0;
    if (grid == 0) {
        if (n_in != 13 || in_sizes[0] != M * D || out_size != M * D || ws_size < WS_END) { fprintf(stderr, "kernel_launch: unexpected shapes (n_in %d, in0 %d, out %d, ws %zu); nothing launched\n", n_in, n_in > 0 ? in_sizes[0] : -1, out_size, ws_size); grid = -1; return; }
        int dev = 0, cus = 0, per_cu = 0;
        if (hipGetDevice(&dev) != hipSuccess || hipDeviceGetAttribute(&cus, hipDeviceAttributeMultiprocessorCount, dev) != hipSuccess) { fprintf(stderr, "kernel_launch: device query failed\n"); grid = -1; return; }
        if (hipFuncSetAttribute((const void*)fwd_mega, hipFuncAttributeMaxDynamicSharedMemorySize, LDS_BYTES) != hipSuccess) { fprintf(stderr, "kernel_launch: hipFuncSetAttribute failed\n"); grid = -1; return; }
        if (hipOccupancyMaxActiveBlocksPerMultiprocessor(&per_cu, (const void*)fwd_mega, NWAVES * 64, LDS_BYTES) != hipSuccess || per_cu < 1) { fprintf(stderr, "kernel_launch: occupancy query says %d blocks per CU\n", per_cu); per_cu = 1; }
        (void)hipGetLastError();
        grid = cus * per_cu;
    }
    if (grid < 0) return;
    if (hipMemsetAsync(d_ws, 0, 16384, stream) != hipSuccess) { fprintf(stderr, "kernel_launch: hipMemsetAsync failed\n"); return; }
    Args a{};
    for (int i = 0; i < 13; ++i) a.in[i] = (const float*)d_in[i];
    a.out = (float*)d_out; a.ws = (unsigned char*)d_ws;
#if MK_N_LAUNCHES == 1
    a.ph_lo = 0; a.ph_hi = 6;
    void* kargs[] = {&a};
    hipError_t e = hipLaunchCooperativeKernel((const void*)fwd_mega, dim3(grid), dim3(NWAVES * 64), kargs, LDS_BYTES, stream);
    if (e != hipSuccess) fprintf(stderr, "kernel_launch: cooperative launch failed: %s (grid %d)\n", hipGetErrorString(e), grid);
#else
    for (int p = 0; p < 6; ++p) { a.ph_lo = p; a.ph_hi = p + 1; hipLaunchKernelGGL(fwd_mega, dim3(grid), dim3(NWAVES * 64), LDS_BYTES, stream, a); }
#endif
}
```

```cpp
#include <hip/hip_runtime.h>
#include <hip/hip_cooperative_groups.h>
#include <cstdio>
#include <cstdint>
namespace cg = cooperative_groups;
constexpr int NWAVES = 8;
constexpr int BATCH = 8, SEQ = 4096, D = 1024, M = BATCH * SEQ;
constexpr int DA = 512, DB = 512, DIN = 5632, NH = 8, HD = 64, NREL = 257;
constexpr float EPS = 1e-6f;
constexpr size_t MiB = 1u << 20;
constexpr size_t WS_RSTD = 1 * MiB;
constexpr size_t WS_WSB = 1 * MiB + 512 * 1024;
constexpr size_t WS_ROWSS = 2 * MiB;
constexpr size_t WS_WIN = 4 * MiB;
constexpr size_t WS_WP = 16 * MiB;
constexpr size_t WS_WO = 18 * MiB;
constexpr size_t WS_XB = 32 * MiB;
constexpr size_t WS_UB = 96 * MiB, WS_VB = 128 * MiB, WS_GB = 160 * MiB;
constexpr size_t WS_GTA = 192 * MiB, WS_GTB = 256 * MiB;
constexpr size_t WS_Y = 320 * MiB;
constexpr size_t WS_MRG = 384 * MiB;
constexpr size_t WS_END = 448 * MiB;
constexpr size_t DO_Q = 0, DO_K = 32 * MiB, DO_VT = 64 * MiB, DO_GA = 96 * MiB;

namespace pg8 {
#define PG8_LAS __attribute__((address_space(3)))
typedef unsigned short bf16_t;
typedef short bf16x8 __attribute__((ext_vector_type(8)));
typedef float f32x4 __attribute__((ext_vector_type(4)));
typedef unsigned u32x4 __attribute__((ext_vector_type(4)));
constexpr int BM = 256, BK = 64, HALF = 128, HTB = HALF * BK * 2  , STAGE_BYTES = 8 * HTB, NXCD = 8, WGM = 8;

__host__ __device__ __forceinline__ int lds_byte(int r, int c) { const int st = (r >> 4) * 2 + (c >> 5), rr = r & 15, cc = c & 31, ob = rr * 64 + cc * 2; return st * 1024 + (ob ^ (((ob >> 9) & 1) << 5)); }
__host__ __device__ __forceinline__ void stage_rc(int b, int& R, int& C) { const int st = b / 1024, sb = b % 1024, swz = sb ^ (((sb >> 9) & 1) << 5); R = (st >> 1) * 16 + swz / 64; C = (st & 1) * 32 + (swz % 64) / 2; }
__host__ __device__ __forceinline__ int perm32(int rho) { const int n = rho >> 4, i = rho & 15; return 8 * (i >> 2) + 4 * n + (i & 3); }

struct Unit { int pm, pn, kh; };
struct Gemm { const bf16_t* A; const bf16_t* Bt; int M, N, K, nt; size_t khstep; };

struct StaticOrder {
    int nM, nN, nwg, G, c;
    __host__ __device__ void init(int M, int N, int G_, int c_) { nM = M / BM; nN = N / BM; nwg = nM * nN; G = G_; c = c_; }
    __host__ __device__ bool next(int i, Unit& u) const {
        const long L = (long)i * G + c; if (L >= nwg) return false;
        int wgid = (int)L; { const int q = nwg / NXCD, r = nwg % NXCD, xcd = wgid % NXCD, off = wgid / NXCD; wgid = (xcd < r ? xcd * (q + 1) : r * (q + 1) + (xcd - r) * q) + off; }
        const int nig = WGM * nN, gid = wgid / nig, fm = gid * WGM, gsz = (nM - fm) < WGM ? (nM - fm) : WGM;
        u.pm = fm + ((wgid % nig) % gsz); u.pn = (wgid % nig) / gsz; u.kh = 0; return true;
    }
    __device__ __forceinline__ void a_ready(const Unit&) const {}
    __device__ __forceinline__ void done(const Unit&) const {}
};
struct SplitKOrder { StaticOrder B;
    __device__ bool next(int i, Unit& u) const { if (!B.next(i >> 1, u)) return false; u.kh = i & 1; return true; }
    __device__ __forceinline__ void a_ready(const Unit&) const {}
    __device__ __forceinline__ void done(const Unit&) const {}
};
typedef float f32x2_cv __attribute__((ext_vector_type(2))); typedef __bf16 bf16x2_cv __attribute__((ext_vector_type(2)));
__device__ __forceinline__ unsigned cvt_pk_bf16(float lo, float hi) { const f32x2_cv v = {lo, hi}; const bf16x2_cv b = __builtin_convertvector(v, bf16x2_cv); return __builtin_bit_cast(unsigned, b); }
typedef float f32x2 __attribute__((ext_vector_type(2)));

constexpr float LOG2E = 1.4426950408889634f;
constexpr float QSCALE = 0.125f * LOG2E;
__device__ __forceinline__ float sigm(float t) { return __builtin_amdgcn_rcpf(1.0f + __builtin_amdgcn_exp2f(-LOG2E * t)); }
__device__ __forceinline__ float bf_lo(unsigned w) { return __uint_as_float(w << 16); }
__device__ __forceinline__ float bf_hi(unsigned w) { return __uint_as_float(w & 0xffff0000u); }

struct EpiIn {
    static constexpr bool PERM = true, AFTER_DRAIN = false, MID = false;
    const float* rstd; const float* b_gate;
    unsigned char* ws; unsigned char* dout;
    __device__ __forceinline__ void operator()(const f32x4 (&acc)[2][2][4][2], const Unit& u, int wr, int wc, int fr, int fq) const {
        const int pn = u.pn, row0 = u.pm * BM + wr * 64 + fr, lc = wc * 32 + 8 * fq;
        if (pn < 4) {
            bf16_t* base = (bf16_t*)(dout + (pn < 2 ? DO_Q : DO_K)); const float sc = pn < 2 ? QSCALE : 1.0f;
#pragma unroll
            for (int ai = 0; ai < 2; ++ai)
#pragma unroll
                for (int m = 0; m < 4; ++m) { const int row = row0 + ai * HALF + m * 16; const float s = rstd[row] * sc;
                    const size_t rowterm = ((size_t)((row >> 12) * 1024 + ((row & 4095) >> 5)) << 11) + (row & 31) * 8;
#pragma unroll
                    for (int bj = 0; bj < 2; ++bj) { const int hcol = (pn & 1) * 4 + bj * 2 + (lc >> 6), d8 = (lc & 63) >> 3;
                        const f32x4 v0 = acc[ai][bj][m][0] * s, v1 = acc[ai][bj][m][1] * s;
                        u32x4 w; w.x = cvt_pk_bf16(v0[0], v0[1]); w.y = cvt_pk_bf16(v0[2], v0[3]); w.z = cvt_pk_bf16(v1[0], v1[1]); w.w = cvt_pk_bf16(v1[2], v1[3]);
                        *(u32x4*)(base + rowterm + ((size_t)hcol << 18) + d8 * 256) = w; } }
        } else if (pn < 6) {
            bf16_t* base = (bf16_t*)(dout + DO_VT);
#pragma unroll
            for (int ai = 0; ai < 2; ++ai)
#pragma unroll
                for (int m = 0; m < 4; ++m) { const int row = row0 + ai * HALF + m * 16, k = row & 31; const float s = rstd[row];
                    const size_t rowterm = ((size_t)((row >> 12) * 1024 + ((row & 4095) >> 5)) << 11) + (k >> 4) * 512 + ((k >> 2) & 1) * 256 + ((k >> 3) & 1) * 4 + (k & 3);
#pragma unroll
                    for (int bj = 0; bj < 2; ++bj) { const int c0 = (pn - 4) * 256 + bj * HALF + lc;
                        bf16_t* p = base + rowterm + ((size_t)(c0 >> 6) << 18) + ((c0 >> 5) & 1) * 1024 + (c0 & 31) * 8;
#pragma unroll
                        for (int n = 0; n < 2; ++n)
#pragma unroll
                            for (int i = 0; i < 4; i += 2) { const unsigned w = cvt_pk_bf16(acc[ai][bj][m][n][i] * s, acc[ai][bj][m][n][i + 1] * s);
                                p[(4 * n + i) * 8] = (bf16_t)(w & 0xffffu); p[(4 * n + i + 1) * 8] = (bf16_t)(w >> 16); } } }
        } else if (pn < 14) {
            const int seg = (pn - 6) >> 1; bf16_t* base = (bf16_t*)(seg == 0 ? dout + DO_GA : ws + WS_UB + (size_t)(seg - 1) * (WS_VB - WS_UB));
            const bool gl = (seg == 1 || seg == 2); const float a1 = gl ? 1.5957691216057308f : 1.0f, a3 = gl ? 1.5957691216057308f * 0.044715f : 0.0f;
            const int col0 = (pn & 1) * 256 + lc;
#pragma unroll
            for (int ai = 0; ai < 2; ++ai)
#pragma unroll
                for (int m = 0; m < 4; ++m) { bf16_t* rowp = base + (size_t)(row0 + ai * HALF + m * 16) * 512 + col0; const float s = rstd[row0 + ai * HALF + m * 16];
#pragma unroll
                    for (int bj = 0; bj < 2; ++bj) { float o[8];
#pragma unroll
                        for (int n = 0; n < 2; ++n)
#pragma unroll
                            for (int i = 0; i < 4; ++i) { const float v = acc[ai][bj][m][n][i] * s; o[4 * n + i] = v * sigm(v * (a1 + a3 * v * v)); }
                        u32x4 w; w.x = cvt_pk_bf16(o[0], o[1]); w.y = cvt_pk_bf16(o[2], o[3]); w.z = cvt_pk_bf16(o[4], o[5]); w.w = cvt_pk_bf16(o[6], o[7]);
                        *(u32x4*)(rowp + bj * HALF) = w; } }
        } else {
            bf16_t* base = (bf16_t*)(ws + (pn < 18 ? WS_GTA : WS_GTB)); const int col0 = ((pn - 14) & 3) * 256 + lc, bcol0 = (pn - 14) * 256 + lc;
#pragma unroll
            for (int ai = 0; ai < 2; ++ai)
#pragma unroll
                for (int m = 0; m < 4; ++m) { bf16_t* rowp = base + (size_t)(row0 + ai * HALF + m * 16) * 1024 + col0; const float s = rstd[row0 + ai * HALF + m * 16];
#pragma unroll
                    for (int bj = 0; bj < 2; ++bj) { float o[8];
#pragma unroll
                        for (int n = 0; n < 2; ++n) { const f32x4 bvv = *(const f32x4*)(b_gate + bcol0 + bj * HALF + 4 * n);
#pragma unroll
                            for (int i = 0; i < 4; ++i) o[4 * n + i] = sigm(acc[ai][bj][m][n][i] * s + bvv[i]); }
                        u32x4 w; w.x = cvt_pk_bf16(o[0], o[1]); w.y = cvt_pk_bf16(o[2], o[3]); w.z = cvt_pk_bf16(o[4], o[5]); w.w = cvt_pk_bf16(o[6], o[7]);
                        *(u32x4*)(rowp + bj * HALF) = w; } }
        }
    }
};

struct EpiMerge {
    static constexpr bool PERM = true, AFTER_DRAIN = false, MID = true;
    const bf16_t *GTA, *GTB; bf16_t* O;
    __device__ __forceinline__ void mid(f32x4 (&acc)[2][2][4][2], const Unit& u, int wr, int wc, int fr, int fq) const {
        const int row0 = u.pm * BM + wr * 64 + fr, col0 = u.pn * BM + wc * 32 + 8 * fq;
#pragma unroll
        for (int ai = 0; ai < 2; ++ai)
#pragma unroll
            for (int m = 0; m < 4; ++m) { const size_t off = (size_t)(row0 + ai * HALF + m * 16) * 1024 + col0;
#pragma unroll
                for (int bj = 0; bj < 2; ++bj) { const u32x4 a = *(const u32x4*)(GTA + off + bj * HALF), b = *(const u32x4*)(GTB + off + bj * HALF);
#pragma unroll
                    for (int j = 0; j < 4; ++j) { const float r0 = bf_lo(a[j]) * __builtin_amdgcn_rcpf(bf_lo(b[j])), r1 = bf_hi(a[j]) * __builtin_amdgcn_rcpf(bf_hi(b[j]));
                        acc[ai][bj][m][j >> 1][(j & 1) * 2] *= r0; acc[ai][bj][m][j >> 1][(j & 1) * 2 + 1] *= r1; } }
                asm volatile("" ::: "memory"); }
    }
    __device__ __forceinline__ void operator()(const f32x4 (&acc)[2][2][4][2], const Unit& u, int wr, int wc, int fr, int fq) const {
        const int row0 = u.pm * BM + wr * 64 + fr, col0 = u.pn * BM + wc * 32 + 8 * fq;
#pragma unroll
        for (int ai = 0; ai < 2; ++ai)
#pragma unroll
            for (int m = 0; m < 4; ++m) { const size_t off = (size_t)(row0 + ai * HALF + m * 16) * 1024 + col0;
#pragma unroll
                for (int bj = 0; bj < 2; ++bj) { const u32x4 b = *(const u32x4*)(GTB + off + bj * HALF); u32x4 w;
#pragma unroll
                    for (int j = 0; j < 4; ++j) w[j] = cvt_pk_bf16(acc[ai][bj][m][j >> 1][(j & 1) * 2] * bf_lo(b[j]), acc[ai][bj][m][j >> 1][(j & 1) * 2 + 1] * bf_hi(b[j]));
                    *(u32x4*)(O + off + bj * HALF) = w; } }
    }
};

struct EpiOut {
    static constexpr bool PERM = false, AFTER_DRAIN = false, MID = false;
    const float* x; const float* fg; float* out; float* rowss;
    __device__ __forceinline__ void operator()(const f32x4 (&acc)[2][2][4][2], const Unit& u, int wr, int wc, int fr, int fq) const {
        const int row0 = u.pm * BM + wr * 64 + fr, col0 = u.pn * BM + wc * 32 + 4 * fq;
        f32x4 gv[2][2];
#pragma unroll
        for (int bj = 0; bj < 2; ++bj)
#pragma unroll
            for (int n = 0; n < 2; ++n) gv[bj][n] = *(const f32x4*)(fg + col0 + bj * HALF + n * 16);
#pragma unroll
        for (int ai = 0; ai < 2; ++ai)
#pragma unroll
            for (int m = 0; m < 4; ++m) { const int row = row0 + ai * HALF + m * 16; const size_t off = (size_t)row * 1024 + col0; float ss = 0.f;
#pragma unroll
                for (int bj = 0; bj < 2; ++bj)
#pragma unroll
                    for (int n = 0; n < 2; ++n) { const f32x4 v = acc[ai][bj][m][n] + *(const f32x4*)(x + off + bj * HALF + n * 16);
                        ss += (v[0] * v[0] + v[1] * v[1]) + (v[2] * v[2] + v[3] * v[3]); *(f32x4*)(out + off + bj * HALF + n * 16) = v * gv[bj][n]; }
                ss += __shfl_xor(ss, 16); ss += __shfl_xor(ss, 32);
                if (fq == 0) rowss[((size_t)u.pn * 32768 + row) * 4 + wc] = ss; }
    }
};
template <class Epi, class Sched, bool ALIGN_EPI = false, bool SP2 = false>
__device__ __forceinline__ void gemm_phase(PG8_LAS unsigned char* lds, const Gemm g, const Sched& S, const Epi& E) {
    const int tid = threadIdx.x, wid = __builtin_amdgcn_readfirstlane(tid >> 6), lane = tid & 63, wr = wid >> 2, wc = wid & 3, fr = lane & 15, fq = lane >> 4;
    const int K = g.K, nt = g.nt;
    unsigned voffA[2], voffB[2];
#pragma unroll
    for (int i = 0; i < 2; ++i) { int R, C; stage_rc(tid * 16 + i * 8192, R, C); const int Rb = Epi::PERM ? ((R & ~31) + perm32(R & 31)) : R;
        voffA[i] = (unsigned)(R * K + C) * 2u; voffB[i] = (unsigned)(Rb * K + C) * 2u; }
    const size_t kstep = (size_t)(BK * 2);
    const size_t hstep = (size_t)HALF * K * 2;
    const size_t tstep = 2 * hstep;
    const unsigned ldsw = (unsigned)wid * 1024u;
    const int aoff = lds_byte(wr * 64 + fr, fq * 8), boff = lds_byte(wc * 32 + fr, fq * 8);
#define PG8_SA(b, h) (((b) * 2 + (h)) * HTB)
#define PG8_SB(b, h) ((4 + (b) * 2 + (h)) * HTB)
#define PG8_STAGE(bufoff, gbase, voff) do { _Pragma("unroll") for (int _i = 0; _i < 2; ++_i) \
        __builtin_amdgcn_global_load_lds((const unsigned*)((const char*)(gbase) + (voff)[_i]), (PG8_LAS unsigned*)(lds + (bufoff) + ldsw + _i * 8192), 16, 0, 0); } while (0)
#define PG8_LDA(dst, b, h) do { _Pragma("unroll") for (int m = 0; m < 4; ++m) _Pragma("unroll") for (int k = 0; k < 2; ++k) dst[m][k] = *(const PG8_LAS bf16x8*)(lds + PG8_SA(b, h) + aoff + m * 2048 + k * 1024); } while (0)
#define PG8_LDB(dst, b, h) do { _Pragma("unroll") for (int n = 0; n < 2; ++n) _Pragma("unroll") for (int k = 0; k < 2; ++k) dst[n][k] = *(const PG8_LAS bf16x8*)(lds + PG8_SB(b, h) + boff + n * 2048 + k * 1024); } while (0)
#define PG8_MMA(ai, bj, At, Bt) do { __builtin_amdgcn_s_setprio(1); _Pragma("unroll") for (int m = 0; m < 4; ++m) _Pragma("unroll") for (int n = 0; n < 2; ++n) _Pragma("unroll") for (int k = 0; k < 2; ++k) \
        acc[ai][bj][m][n] = __builtin_amdgcn_mfma_f32_16x16x32_bf16(Bt[n][k], At[m][k], acc[ai][bj][m][n], 0, 0, 0); __builtin_amdgcn_s_setprio(0); } while (0)
#define PG8_WAIT_V(n) asm volatile("s_waitcnt vmcnt(" #n ")" ::: "memory")
#define PG8_WAIT_L(n) asm volatile("s_waitcnt lgkmcnt(" #n ")" ::: "memory")
#define PG8_BAR __builtin_amdgcn_s_barrier()
#define PG8_SCHED __builtin_amdgcn_sched_barrier(0)
    Unit cur, nxt; int ui = 0;
    if (!S.next(0, cur)) return;
    f32x4 acc[2][2][4][2];
#pragma unroll
    for (int a = 0; a < 2; ++a)
#pragma unroll
        for (int b = 0; b < 2; ++b)
#pragma unroll
            for (int m = 0; m < 4; ++m)
#pragma unroll
                for (int n = 0; n < 2; ++n) acc[a][b][m][n] = (f32x4){0.f, 0.f, 0.f, 0.f};
    bf16x8 At[4][2], B0[2][2], B1[2][2];
    const char* cA = (const char*)g.A + (size_t)cur.pm * tstep + (size_t)cur.kh * g.khstep; const char* cB = (const char*)g.Bt + (size_t)cur.pn * tstep + (size_t)cur.kh * g.khstep;
    S.a_ready(cur);
    if constexpr (SP2) {
        PG8_STAGE(PG8_SB(0, 0), cB, voffB); PG8_STAGE(PG8_SB(0, 1), cB + hstep, voffB); PG8_STAGE(PG8_SA(0, 0), cA, voffA); PG8_STAGE(PG8_SA(0, 1), cA + hstep, voffA);
        if (wr == 1) PG8_BAR;
        PG8_WAIT_V(2); PG8_BAR;
        PG8_STAGE(PG8_SB(1, 0), cB + kstep, voffB); PG8_STAGE(PG8_SA(1, 0), cA + kstep, voffA); PG8_STAGE(PG8_SB(1, 1), cB + hstep + kstep, voffB);
        PG8_WAIT_V(6); PG8_BAR;
    } else {
        PG8_STAGE(PG8_SB(0, 0), cB, voffB); PG8_STAGE(PG8_SA(0, 0), cA, voffA); PG8_STAGE(PG8_SB(0, 1), cB + hstep, voffB); PG8_STAGE(PG8_SA(0, 1), cA + hstep, voffA);
        if (wr == 1) PG8_BAR;
        PG8_WAIT_V(4); PG8_BAR;
        PG8_STAGE(PG8_SB(1, 0), cB + kstep, voffB); PG8_STAGE(PG8_SA(1, 0), cA + kstep, voffA); PG8_STAGE(PG8_SB(1, 1), cB + hstep + kstep, voffB);
        PG8_WAIT_V(6); PG8_BAR;
    }
    for (;;) {
        const bool has_next = S.next(ui + 1, nxt);
        const char* nA = has_next ? (const char*)g.A + (size_t)nxt.pm * tstep + (size_t)nxt.kh * g.khstep : cA; const char* nB = has_next ? (const char*)g.Bt + (size_t)nxt.pn * tstep + (size_t)nxt.kh * g.khstep : cB;
        for (int t = 0; t < nt; t += 2) {
            const bool last = (t == nt - 2);
            const char* a1 = cA + (size_t)(t + 1) * kstep;
            const char* a2 = last ? nA : cA + (size_t)(t + 2) * kstep; const char* b2 = last ? nB : cB + (size_t)(t + 2) * kstep;
            const char* a3 = a2 + kstep; const char* b3 = b2 + kstep;
            if (last && has_next) S.a_ready(nxt);
            if constexpr (SP2) {
            PG8_LDB(B0, 0, 0); PG8_LDB(B1, 0, 1); PG8_SCHED; PG8_LDA(At, 0, 0); PG8_STAGE(PG8_SA(1, 1), a1 + hstep, voffA);
            PG8_WAIT_V(8); PG8_WAIT_L(0); PG8_BAR; PG8_MMA(0, 0, At, B0); PG8_MMA(0, 1, At, B1); PG8_BAR; PG8_SCHED;
            PG8_LDA(At, 0, 1); PG8_STAGE(PG8_SB(0, 0), b2, voffB); PG8_STAGE(PG8_SB(0, 1), b2 + hstep, voffB); PG8_STAGE(PG8_SA(0, 0), a2, voffA);
            PG8_WAIT_V(8); PG8_WAIT_L(0); PG8_BAR; PG8_MMA(1, 0, At, B0); PG8_MMA(1, 1, At, B1); PG8_BAR; PG8_SCHED;
            PG8_LDB(B0, 1, 0); PG8_LDB(B1, 1, 1); PG8_SCHED; PG8_LDA(At, 1, 0); PG8_STAGE(PG8_SA(0, 1), a2 + hstep, voffA);
            PG8_WAIT_V(8); PG8_WAIT_L(0); PG8_BAR; PG8_MMA(0, 0, At, B0); PG8_MMA(0, 1, At, B1); PG8_BAR; PG8_SCHED;
            PG8_LDA(At, 1, 1); PG8_STAGE(PG8_SB(1, 0), b3, voffB); PG8_STAGE(PG8_SB(1, 1), b3 + hstep, voffB); PG8_STAGE(PG8_SA(1, 0), a3, voffA);
            PG8_WAIT_V(8); PG8_WAIT_L(0); PG8_BAR; PG8_MMA(1, 0, At, B0); PG8_MMA(1, 1, At, B1); PG8_BAR; PG8_SCHED;
            } else {
            PG8_LDB(B0, 0, 0); PG8_SCHED; PG8_LDA(At, 0, 0); PG8_STAGE(PG8_SA(1, 1), a1 + hstep, voffA);
            PG8_WAIT_L(8); PG8_BAR; PG8_WAIT_L(0); PG8_MMA(0, 0, At, B0); PG8_BAR; PG8_SCHED;
            PG8_LDB(B1, 0, 1); PG8_STAGE(PG8_SB(0, 0), b2, voffB);
            PG8_BAR; PG8_WAIT_L(0); PG8_MMA(0, 1, At, B1); PG8_BAR;
            PG8_LDA(At, 0, 1); PG8_STAGE(PG8_SA(0, 0), a2, voffA);
            PG8_BAR; PG8_WAIT_L(0); PG8_MMA(1, 0, At, B0); PG8_BAR; PG8_SCHED;
            PG8_STAGE(PG8_SB(0, 1), b2 + hstep, voffB);
            PG8_WAIT_V(6); PG8_BAR; PG8_MMA(1, 1, At, B1); PG8_BAR;
            PG8_LDB(B0, 1, 0); PG8_SCHED; PG8_LDA(At, 1, 0); PG8_STAGE(PG8_SA(0, 1), a2 + hstep, voffA);
            PG8_WAIT_L(8); PG8_BAR; PG8_WAIT_L(0); PG8_MMA(0, 0, At, B0); PG8_BAR; PG8_SCHED;
            PG8_LDB(B1, 1, 1); PG8_STAGE(PG8_SB(1, 0), b3, voffB);
            PG8_BAR; PG8_WAIT_L(0); PG8_MMA(0, 1, At, B1); PG8_BAR;
            PG8_LDA(At, 1, 1); PG8_STAGE(PG8_SA(1, 0), a3, voffA);
            PG8_BAR; PG8_WAIT_L(0); PG8_MMA(1, 0, At, B0); PG8_BAR; PG8_SCHED;
            PG8_STAGE(PG8_SB(1, 1), b3 + hstep, voffB);
            PG8_WAIT_V(6); PG8_BAR; PG8_MMA(1, 1, At, B1); PG8_BAR;
            }
        }
        if constexpr (ALIGN_EPI) { if (wr == 0) PG8_BAR; }
        bool keep = false;
        if constexpr (Epi::MID) { if (cur.kh == 0) { E.mid(acc, cur, wr, wc, fr, fq); keep = true; } else E(acc, cur, wr, wc, fr, fq); }
        else if constexpr (!Epi::AFTER_DRAIN) { E(acc, cur, wr, wc, fr, fq); S.done(cur); }
        if (!has_next) break;
        if (!keep)
#pragma unroll
        for (int a = 0; a < 2; ++a)
#pragma unroll
            for (int b = 0; b < 2; ++b)
#pragma unroll
                for (int m = 0; m < 4; ++m)
#pragma unroll
                    for (int n = 0; n < 2; ++n) acc[a][b][m][n] = (f32x4){0.f, 0.f, 0.f, 0.f};
        cur = nxt; cA = nA; cB = nB; ++ui;
        if constexpr (ALIGN_EPI) { if (wr == 1) PG8_BAR; }
    }
    PG8_WAIT_V(0);
    if constexpr (!ALIGN_EPI) { if (wr == 0) PG8_BAR; }
    PG8_BAR;
    if constexpr (Epi::AFTER_DRAIN) { E.fused(acc, cur, wr, wc, fr, fq, lds, wid, lane); S.done(cur); }
#undef PG8_SA
#undef PG8_SB
#undef PG8_STAGE
#undef PG8_LDA
#undef PG8_LDB
#undef PG8_MMA
#undef PG8_WAIT_V
#undef PG8_WAIT_L
#undef PG8_BAR
#undef PG8_SCHED
}
}

#ifndef PG8_SP2
#define PG8_SP2 true
#endif
#ifndef PG8_ALIGN
#define PG8_ALIGN true
#endif
#ifndef REP_PHASE
#define REP_PHASE (-1)
#endif

constexpr int LDS_BYTES = 147456;

#define GAS __attribute__((address_space(1)))
#define LAS __attribute__((address_space(3)))
typedef unsigned short bf16;
typedef unsigned v4u __attribute__((ext_vector_type(4)));
typedef unsigned v2u __attribute__((ext_vector_type(2)));
typedef float f32x4 __attribute__((ext_vector_type(4)));
typedef float f32x16 __attribute__((ext_vector_type(16)));
typedef short bf16x8 __attribute__((ext_vector_type(8)));
using pg8::cvt_pk_bf16; using pg8::bf_lo; using pg8::bf_hi; using pg8::LOG2E;
#define LDS_WAIT() asm volatile("s_waitcnt lgkmcnt(0)" ::: "memory")
__device__ __forceinline__ unsigned f2bf(float f) { unsigned u = __builtin_bit_cast(unsigned, f); return (u + 0x7fffu + ((u >> 16) & 1u)) >> 16; }
__device__ __forceinline__ unsigned pk2(float lo, float hi) { return f2bf(lo) | (f2bf(hi) << 16); }
__device__ __forceinline__ float wave_sum(float v) {
#pragma unroll
    for (int o = 1; o < 64; o <<= 1) v += __shfl_xor(v, o);
    return v;
}
__device__ __forceinline__ int crow(int r, int hi) { return (r & 3) + 8 * (r >> 2) + 4 * hi; }

#define XB_TMO      128
#define XB_XCNT(j)  (256  + 64 * (j))
#define XB_XSUB(j)  (1280 + 64 * (j))
#define XB_XGEN(j)  (2304 + 64 * (j))
#define XB_TOP      3328
#define XB_TOPGEN   3392
#define XCD_BAR_WORDS 3456
#define XB_SPIN_CAP (1u << 18)

__device__ __forceinline__ unsigned xb_ld(unsigned* p)              { return __hip_atomic_load(p, __ATOMIC_RELAXED, __HIP_MEMORY_SCOPE_AGENT); }
__device__ __forceinline__ unsigned xb_add(unsigned* p, unsigned v) { return __hip_atomic_fetch_add(p, v, __ATOMIC_RELAXED, __HIP_MEMORY_SCOPE_AGENT); }
__device__ __forceinline__ unsigned xb_xcc_id() { return (unsigned)__builtin_amdgcn_s_getreg((3 << 11) | 20) & 0xFu; }
#define XB_SPIN(cond, bar) do { unsigned _sp = 0; while (cond) { __builtin_amdgcn_s_sleep(1); \
    if ((++_sp & 255u) == 0u) { if (xb_ld(&(bar)[XB_TMO])) break; if (_sp > XB_SPIN_CAP) { atomicAdd(&(bar)[XB_TMO], 1u); break; } } } } while (0)

struct XcdBarrier {
    unsigned* bar; unsigned x;
    volatile LAS unsigned* st;
};

__device__ __forceinline__ XcdBarrier xcd_barrier_post(unsigned* bar, volatile LAS unsigned* st) {
    XcdBarrier b; b.bar = bar; b.x = xb_xcc_id(); b.st = st;
    if (threadIdx.x == 0) (void)xb_add(&bar[XB_XCNT(b.x)], 1u);
    return b;
}
__device__ __forceinline__ void xcd_barrier_complete(unsigned* bar, unsigned x, unsigned& nloc, unsigned& nx) {
    const unsigned G = gridDim.x * gridDim.y * gridDim.z;
    unsigned sum, cnt, mine, sp = 0u;
    for (;;) {
        sum = 0u; cnt = 0u; mine = 0u;
#pragma unroll
        for (unsigned j = 0; j < 16; ++j) { const unsigned c = xb_ld(&bar[XB_XCNT(j)]); sum += c; cnt += (c > 0u) ? 1u : 0u; mine = (j == x) ? c : mine; }
        if (sum == G) break;
        __builtin_amdgcn_s_sleep(1);
        if ((++sp & 255u) == 0u) { if (xb_ld(&bar[XB_TMO])) break; if (sp > XB_SPIN_CAP) { atomicAdd(&bar[XB_TMO], 1u); break; } }
    }
    nloc = mine > 0u ? mine : 1u; nx = cnt > 0u ? cnt : 1u;
}

__device__ __forceinline__ void xcd_barrier(const XcdBarrier& b) {
    asm volatile("s_waitcnt vmcnt(0)" ::: "memory");
    __syncthreads();
    if (threadIdx.x == 0) {
        unsigned* bar = b.bar;
        __builtin_amdgcn_s_waitcnt(0);
        unsigned nloc = b.st[0], nx = b.st[1];
        if (nloc == 0u) { xcd_barrier_complete(bar, b.x, nloc, nx); b.st[0] = nloc; b.st[1] = nx; }
        const unsigned old = xb_add(&bar[XB_XSUB(b.x)], 1u);
        const unsigned gen = old / nloc;
        if (old + 1u == (gen + 1u) * nloc) {
            __builtin_amdgcn_fence(__ATOMIC_RELEASE, "agent");
            asm volatile("s_waitcnt vmcnt(0)" ::: "memory");
            const unsigned og = xb_add(&bar[XB_TOP], 1u);
            const unsigned tg = og / nx;
            if (og + 1u == (tg + 1u) * nx) xb_add(&bar[XB_TOPGEN], 1u);
            else XB_SPIN(xb_ld(&bar[XB_TOPGEN]) == tg, bar);
            __builtin_amdgcn_fence(__ATOMIC_ACQUIRE, "agent");
            xb_add(&bar[XB_XGEN(b.x)], 1u);
            asm volatile("s_waitcnt vmcnt(0)" ::: "memory");
        } else {
            XB_SPIN(xb_ld(&bar[XB_XGEN(b.x)]) == gen, bar);
            __builtin_amdgcn_fence(__ATOMIC_ACQUIRE, "agent");
            asm volatile("s_waitcnt vmcnt(0)" ::: "memory");
        }
    }
    __syncthreads();
}

struct Args { const float* in[13]; float* out; unsigned char* ws; int ph_lo, ph_hi; };

__device__ __forceinline__ void p0_transpose_item(const float* W, int N, bf16* WT, int ldo, int koff, const float* scale, LAS float* scr, int item, int lane) {
    const int nblk = N / 32, kb = item / nblk, nb = item % nblk, k0 = 64 * kb, n0 = 32 * nb;
#pragma unroll 8
    for (int i = 0; i < 32; ++i) { const int kk = 2 * i + (lane >> 5); const float sc = scale ? scale[k0 + kk] : 1.0f; scr[kk * 33 + (lane & 31)] = W[(size_t)(k0 + kk) * N + n0 + (lane & 31)] * sc; }
    LDS_WAIT(); asm volatile("" ::: "memory");
    const int c = lane & 7;
#pragma unroll
    for (int j = 0; j < 4; ++j) { const int n = (lane >> 3) + 8 * j; const LAS float* s = scr + (8 * c) * 33 + n;
        v4u o; o.x = pk2(s[0 * 33], s[1 * 33]); o.y = pk2(s[2 * 33], s[3 * 33]); o.z = pk2(s[4 * 33], s[5 * 33]); o.w = pk2(s[6 * 33], s[7 * 33]);
        *(GAS v4u*)(WT + (size_t)(n0 + n) * ldo + koff + k0 + 8 * c) = o; }
    LDS_WAIT(); asm volatile("" ::: "memory");
}
__device__ __forceinline__ void p0_prologue(const Args& a, LAS unsigned char* lds, int gw, int NGW, int wave, int lane) {
    unsigned char* ws = a.ws;
    LAS float* scr = (LAS float*)(lds + wave * 16384);
    constexpr int I_IN = (D / 64) * (DIN / 32), I_P = (512 / 64) * (D / 32), I_O = (D / 64) * (D / 32);
    constexpr int NITEMS = I_IN + 2 * I_P + I_O;
    for (int it = gw; it < NITEMS; it += NGW) {
        int r = it;
        if (r < I_IN) { p0_transpose_item(a.in[2], DIN, (bf16*)(ws + WS_WIN), D, 0, a.in[1], scr, r, lane); continue; } r -= I_IN;
        if (r < I_P) { p0_transpose_item(a.in[9], D, (bf16*)(ws + WS_WP), D, 0, nullptr, scr, r, lane); continue; } r -= I_P;
        if (r < I_P) { p0_transpose_item(a.in[10], D, (bf16*)(ws + WS_WP), D, 512, nullptr, scr, r, lane); continue; } r -= I_P;
        p0_transpose_item(a.in[11], D, (bf16*)(ws + WS_WO), D, 0, nullptr, scr, r, lane);
    }
    { const float* w = a.in[7]; bf16* o = (bf16*)(ws + WS_WSB);
      for (int i = gw * 64 + lane; i < 4 * 128 * 128; i += NGW * 64) { const int t = (i >> 7) & 127, s = i & 127; o[i] = (bf16)f2bf(s <= t ? w[i] : 0.0f); } }
    const float* x = a.in[0]; bf16* xb = (bf16*)(ws + WS_XB); float* rstd = (float*)(ws + WS_RSTD);
    const int rows_per = (M + NGW - 1) / NGW;
    for (int m = gw * rows_per; m < M && m < (gw + 1) * rows_per; ++m) {
        const GAS f32x4* xr = (const GAS f32x4*)(x + (size_t)m * D) + lane;
        f32x4 v[4]; float s = 0.f;
#pragma unroll
        for (int j = 0; j < 4; ++j) { v[j] = xr[64 * j]; s += (v[j].x * v[j].x + v[j].y * v[j].y) + (v[j].z * v[j].z + v[j].w * v[j].w); }
        s = wave_sum(s);
        if (lane == 0) rstd[m] = 1.0f / sqrtf(s * (1.0f / D) + EPS);
        GAS unsigned long long* o8 = (GAS unsigned long long*)(xb + (size_t)m * D) + lane;
#pragma unroll
        for (int j = 0; j < 4; ++j) o8[64 * j] = (unsigned long long)pk2(v[j].x, v[j].y) | ((unsigned long long)pk2(v[j].z, v[j].w) << 32);
    }
}

__device__ __forceinline__ float xhalf_max(float m) { auto rr = __builtin_amdgcn_permlane32_swap(__float_as_uint(m), __float_as_uint(m), false, false); return fmaxf(__uint_as_float(rr[0]), __uint_as_float(rr[1])); }
__device__ __forceinline__ float xhalf_sum(float m) { auto rr = __builtin_amdgcn_permlane32_swap(__float_as_uint(m), __float_as_uint(m), false, false); return __uint_as_float(rr[0]) + __uint_as_float(rr[1]); }
constexpr float ATT_THR = 8.0f;
__device__ __forceinline__ void attn_phase(const bf16* Q, const bf16* Kb, const bf16* Vt, const bf16* GA, bf16* Y, const float* rel_bias, LAS float* BT, int gw, int NGW, int tid, int lane) {
    asm volatile("" : "+v"(lane), "+v"(tid));
    const int hh = (gw >> 6) & 7;
    for (int idx = tid; idx < 6 * 2 * 4 * 64 * 4; idx += NWAVES * 64) { const int e = idx & 3, ln = (idx >> 2) & 63, g = (idx >> 8) & 3, qb = (idx >> 10) & 1, nb = idx >> 11;
        int dist = (qb * 32 + (ln & 31)) - ((nb - 4) * 32 + crow(4 * g + e, ln >> 5)); dist = dist < -128 ? -128 : (dist > 128 ? 128 : dist);
        BT[idx] = rel_bias[hh * NREL + dist + 128] * LOG2E; }
    const float cfar = rel_bias[hh * NREL + 256] * LOG2E;
    __syncthreads();
    const int r32 = lane & 31, hi = lane >> 5;
    for (int item = gw; item < BATCH * NH * 64; item += NGW) {
        const int bh = item >> 6, c = item & 63, b = bh >> 3, h = bh & 7;
        const int tok0 = b * SEQ + c * 64;
        const unsigned flane = (unsigned)(lane * 16);
        const unsigned galane = (unsigned)(r32 * 1024 + hi * 8), ylane = (unsigned)(r32 * 2048 + hi * 8);
        bf16x8 qf[2][4];
        { const char* qb_ = (const char*)Q + ((size_t)(bh * 128 + c * 2) << 12);
#pragma unroll
          for (int qb = 0; qb < 2; ++qb)
#pragma unroll
            for (int d0 = 0; d0 < 4; ++d0) qf[qb][d0] = *(const bf16x8*)((qb_ + (qb * 4096 + d0 * 1024)) + flane); }
        f32x16 o[2][2];
#pragma unroll
        for (int x = 0; x < 2; ++x)
#pragma unroll
            for (int y = 0; y < 2; ++y)
#pragma unroll
                for (int i = 0; i < 16; ++i) o[x][y][i] = 0.f;
        float mref[2] = {0.f, 0.f}, lrow[2] = {0.f, 0.f};
        const int jstart = c < 8 ? 8 - c : 0;
#define ATT_LOAD_K(BLK, KF) do { const char* kb_ = (const char*)Kb + ((size_t)(bh * 128 + c * 2 + (BLK) - 16) << 12);     \
            _Pragma("unroll") for (int d0 = 0; d0 < 4; ++d0) KF[d0] = *(const bf16x8*)((kb_ + d0 * 1024) + flane); } while (0)
#define ATT_LOAD_V(BLK, VF) do { const char* vb_ = (const char*)Vt + ((size_t)(bh * 128 + c * 2 + (BLK) - 16) << 12); \
            _Pragma("unroll") for (int db = 0; db < 2; ++db) _Pragma("unroll") for (int s = 0; s < 2; ++s) VF[db][s] = *(const bf16x8*)((vb_ + (db * 2 + s) * 1024) + flane); } while (0)
        bf16x8 kf[4];
        ATT_LOAD_K(jstart * 2, kf);
        for (int blk = jstart * 2; blk < 18; ++blk) {
            const bool first = (blk == jstart * 2);
            bf16x8 vf[2][2];
            ATT_LOAD_V(blk, vf);
            bf16x8 kfn[4];
            if (blk + 1 < 18) ATT_LOAD_K(blk + 1, kfn);
#pragma unroll
            for (int qb = 0; qb < 2; ++qb) {
                f32x16 sc;
                if (blk < 12) { const float cm = cfar - mref[qb];
#pragma unroll
                    for (int i = 0; i < 16; ++i) sc[i] = cm;
                } else { const LAS f32x4* bt = (const LAS f32x4*)BT + ((blk - 12) * 2 + qb) * 256 + lane;
#pragma unroll
                    for (int g = 0; g < 4; ++g) { const f32x4 t = bt[g * 64]; sc[4 * g] = t[0] - mref[qb]; sc[4 * g + 1] = t[1] - mref[qb]; sc[4 * g + 2] = t[2] - mref[qb]; sc[4 * g + 3] = t[3] - mref[qb]; }
                }
#pragma unroll
                for (int d0 = 0; d0 < 4; ++d0) sc = __builtin_amdgcn_mfma_f32_32x32x16_bf16(kf[d0], qf[qb][d0], sc, 0, 0, 0);
                float ma = fmaxf(fmaxf(sc[0], sc[1]), sc[2]), mb = fmaxf(fmaxf(sc[3], sc[4]), sc[5]);
                ma = fmaxf(fmaxf(ma, sc[6]), sc[7]); mb = fmaxf(fmaxf(mb, sc[8]), sc[9]); ma = fmaxf(fmaxf(ma, sc[10]), sc[11]); mb = fmaxf(fmaxf(mb, sc[12]), sc[13]); ma = fmaxf(fmaxf(ma, sc[14]), sc[15]);
                const float mx = xhalf_max(fmaxf(ma, mb));
                if (first) {
                    mref[qb] += mx;
#pragma unroll
                    for (int i = 0; i < 16; ++i) sc[i] -= mx;
                } else if (__builtin_expect(__any(mx > ATT_THR), 0)) {
                    const float dl = fmaxf(mx, 0.f), alpha = __builtin_amdgcn_exp2f(-dl);
                    mref[qb] += dl; lrow[qb] *= alpha;
#pragma unroll
                    for (int i = 0; i < 16; ++i) sc[i] -= dl;
#pragma unroll
                    for (int db = 0; db < 2; ++db)
#pragma unroll
                        for (int i = 0; i < 16; ++i) o[db][qb][i] *= alpha;
                }
                float ps = 0.f;
#pragma unroll
                for (int i = 0; i < 16; ++i) { const float p = __builtin_amdgcn_exp2f(sc[i]); sc[i] = p; ps += p; }
                lrow[qb] += ps;
#pragma unroll
                for (int s = 0; s < 2; ++s) { v4u w;
                    w.x = cvt_pk_bf16(sc[8 * s + 0], sc[8 * s + 1]); w.y = cvt_pk_bf16(sc[8 * s + 2], sc[8 * s + 3]);
                    w.z = cvt_pk_bf16(sc[8 * s + 4], sc[8 * s + 5]); w.w = cvt_pk_bf16(sc[8 * s + 6], sc[8 * s + 7]);
                    const bf16x8 pfr = __builtin_bit_cast(bf16x8, w);
#pragma unroll
                    for (int db = 0; db < 2; ++db) o[db][qb] = __builtin_amdgcn_mfma_f32_32x32x16_bf16(vf[db][s], pfr, o[db][qb], 0, 0, 0); }
                __builtin_amdgcn_sched_barrier(0);
            }
            if (blk + 1 < 18) {
#pragma unroll
                for (int d0 = 0; d0 < 4; ++d0) kf[d0] = kfn[d0];
            }
        }
#pragma unroll
        for (int qb = 0; qb < 2; ++qb) {
            const float l = xhalf_sum(lrow[qb]), inv = 1.0f / l;
            const char* ga_ = (const char*)GA + ((size_t)(tok0 + qb * 32) * 512 + h * 64) * 2; char* y_ = (char*)Y + ((size_t)(tok0 + qb * 32) * 1024 + h * 64) * 2;
#pragma unroll
            for (int db = 0; db < 2; ++db)
#pragma unroll
                for (int g4 = 0; g4 < 4; ++g4) { const int dofs = (db * 32 + 8 * g4) * 2;
                    const v2u g = *(const v2u*)((ga_ + dofs) + galane); v2u w;
                    w.x = cvt_pk_bf16(o[db][qb][4 * g4 + 0] * inv * bf_lo(g.x), o[db][qb][4 * g4 + 1] * inv * bf_hi(g.x));
                    w.y = cvt_pk_bf16(o[db][qb][4 * g4 + 2] * inv * bf_lo(g.y), o[db][qb][4 * g4 + 3] * inv * bf_hi(g.y));
                    *(v2u*)((y_ + dofs) + ylane) = w; }
        }
    }
#undef ATT_LOAD_K
#undef ATT_LOAD_V
}

constexpr int SGU_PITCH = 264;
__device__ __forceinline__ void sgu_phase(const bf16* UB, const bf16* VB, const bf16* GB, bf16* Y, const float* ln_g, const float* ln_b, const bf16* Wsb, const float* b_s,
                                          LAS unsigned char* img, int first, int step, int wave, int lane) {
    asm volatile("" : "+v"(lane));
    const int r32 = lane & 31, hi = lane >> 5;
    for (int unit = first; unit < M / 128; unit += step) {
        const int tok0 = unit * 128;
        LAS float* stats = (LAS float*)(img + 512 * SGU_PITCH);
#pragma unroll 1
        for (int hb = 0; hb < 2; ++hb) { v4u raw[8];
#pragma unroll
          for (int tt = 0; tt < 8; ++tt) raw[tt] = *(const v4u*)(VB + (size_t)(tok0 + wave * 16 + hb * 8 + tt) * 512 + lane * 8);
#pragma unroll
          for (int tt = 0; tt < 8; ++tt) { float a = 0.f, q = 0.f;
#pragma unroll
              for (int j = 0; j < 4; ++j) { const float x0 = bf_lo(raw[tt][j]), x1 = bf_hi(raw[tt][j]); a += x0 + x1; q += x0 * x0 + x1 * x1; }
              a = wave_sum(a) * (1.0f / 512.0f); q = wave_sum(q) * (1.0f / 512.0f);
              if (lane == 0) { stats[(wave * 16 + hb * 8 + tt) * 2] = a; stats[(wave * 16 + hb * 8 + tt) * 2 + 1] = 1.0f / sqrtf(fmaxf(q - a * a, 0.f) + EPS); } } }
        LDS_WAIT();
        float gam[8], bet[8];
#pragma unroll
        for (int e = 0; e < 8; ++e) { gam[e] = ln_g[lane + 64 * e]; bet[e] = ln_b[lane + 64 * e]; }
#pragma unroll 2
        for (int tt = 0; tt < 16; tt += 2) {
            const int s0 = wave * 16 + tt;
            unsigned short h0[8], h1[8];
#pragma unroll
            for (int e = 0; e < 8; ++e) { h0[e] = VB[(size_t)(tok0 + s0) * 512 + lane + 64 * e]; h1[e] = VB[(size_t)(tok0 + s0 + 1) * 512 + lane + 64 * e]; }
            const f32x4 st = *(const LAS f32x4*)(stats + s0 * 2);
#pragma unroll
            for (int e = 0; e < 8; ++e) { const float x0 = __uint_as_float((unsigned)h0[e] << 16), x1 = __uint_as_float((unsigned)h1[e] << 16);
                *(LAS unsigned*)(img + (lane + 64 * e) * SGU_PITCH + s0 * 2) = cvt_pk_bf16((x0 - st[0]) * st[1] * gam[e] + bet[e], (x1 - st[2]) * st[3] * gam[e] + bet[e]); }
        }
        __syncthreads();
        const int g = wave >> 1, ch = wave & 1;
        bf16x8 af[2][8];
#pragma unroll
        for (int cb = 0; cb < 2; ++cb)
#pragma unroll
            for (int kk = 0; kk < 8; ++kk) { const LAS unsigned char* p = img + (g * 128 + ch * 64 + cb * 32 + r32) * SGU_PITCH + kk * 32 + hi * 16;
                const v2u lo = *(const LAS v2u*)p, hv = *(const LAS v2u*)(p + 8); v4u w; w.x = lo.x; w.y = lo.y; w.z = hv.x; w.w = hv.y; af[cb][kk] = __builtin_bit_cast(bf16x8, w); }
#pragma unroll
        for (int tb = 0; tb < 4; ++tb) {
            f32x16 acc[2];
#pragma unroll
            for (int cb = 0; cb < 2; ++cb)
#pragma unroll
                for (int i = 0; i < 16; ++i) acc[cb][i] = 0.f;
            const int t = tb * 32 + r32;
#pragma unroll
            for (int kk = 0; kk < 2 * tb + 2; ++kk) {
                const bf16x8 bfr = *(const bf16x8*)(Wsb + (size_t)(g * 128 + t) * 128 + kk * 16 + hi * 8);
#pragma unroll
                for (int cb = 0; cb < 2; ++cb) acc[cb] = __builtin_amdgcn_mfma_f32_32x32x16_bf16(af[cb][kk], bfr, acc[cb], 0, 0, 0);
            }
            const float bs = b_s[g * 128 + t]; const size_t tok = (size_t)(tok0 + t);
#pragma unroll
            for (int cb = 0; cb < 2; ++cb)
#pragma unroll
                for (int g4 = 0; g4 < 4; ++g4) { const int cc = g * 128 + ch * 64 + cb * 32 + 8 * g4 + 4 * hi;
                    const v2u uu = *(const v2u*)(UB + tok * 512 + cc), gg = *(const v2u*)(GB + tok * 512 + cc); v2u w;
                    w.x = cvt_pk_bf16(bf_lo(uu.x) * (acc[cb][4 * g4 + 0] + bs) * bf_lo(gg.x), bf_hi(uu.x) * (acc[cb][4 * g4 + 1] + bs) * bf_hi(gg.x));
                    w.y = cvt_pk_bf16(bf_lo(uu.y) * (acc[cb][4 * g4 + 2] + bs) * bf_lo(gg.y), bf_hi(uu.y) * (acc[cb][4 * g4 + 3] + bs) * bf_hi(gg.y));
                    *(v2u*)(Y + tok * 1024 + 512 + cc) = w; }
        }
        __syncthreads();
    }
}

__device__ __forceinline__ void final_phase(float* out, const float* rowss, int gw, int NGW, int lane) {
    for (int m = gw; m < M; m += NGW) {
        const f32x4* rp = (const f32x4*)rowss + m;
        const f32x4 a = rp[0], b = rp[M], c = rp[2 * M], d = rp[3 * M];
        const float ss = (((a.x + a.y) + (a.z + a.w)) + ((b.x + b.y) + (b.z + b.w))) + (((c.x + c.y) + (c.z + c.w)) + ((d.x + d.y) + (d.z + d.w)));
        const float r = 1.0f / sqrtf(ss * (1.0f / D) + EPS);
        GAS f32x4* o = (GAS f32x4*)(out + (size_t)m * D) + lane;
#pragma unroll
        for (int j = 0; j < 4; ++j) o[64 * j] = o[64 * j] * r;
    }
}

__device__ __forceinline__ void ph1(unsigned char* ws, unsigned char* dout, const float* b_gate, LAS unsigned char* lds, int G, int bx) {
    pg8::Gemm g{(const bf16*)(ws + WS_XB), (const bf16*)(ws + WS_WIN), M, DIN, D, D / 64, 0}; pg8::StaticOrder S; S.init(M, DIN, G, bx);
    pg8::EpiIn E{(const float*)(ws + WS_RSTD), b_gate, ws, dout};
    pg8::gemm_phase<pg8::EpiIn, pg8::StaticOrder, PG8_ALIGN, PG8_SP2>(lds, g, S, E);
}
__device__ __forceinline__ void ph2(const Args& args, unsigned char* ws, unsigned char* dout, LAS unsigned char* lds, int G, int bx, int gw, int NGW, int tid, int wave, int lane) {
    __syncthreads();
#ifndef NO_SGU
    sgu_phase((const bf16*)(ws + WS_UB), (const bf16*)(ws + WS_VB), (const bf16*)(ws + WS_GB), (bf16*)(ws + WS_Y), args.in[5], args.in[6], (const bf16*)(ws + WS_WSB), args.in[8],
              lds, bx, G, wave, lane);
#if REP_PHASE == 20
    sgu_phase((const bf16*)(ws + WS_UB), (const bf16*)(ws + WS_VB), (const bf16*)(ws + WS_GB), (bf16*)(ws + WS_Y), args.in[5], args.in[6], (const bf16*)(ws + WS_WSB), args.in[8],
              lds, bx, G, wave, lane);
#endif
#endif
#ifndef NO_ATT
    attn_phase((const bf16*)(dout + DO_Q), (const bf16*)(dout + DO_K), (const bf16*)(dout + DO_VT), (const bf16*)(dout + DO_GA), (bf16*)(ws + WS_Y), args.in[4],
               (LAS float*)lds, gw, NGW, tid, lane);
#if REP_PHASE == 21
    __syncthreads();
    attn_phase((const bf16*)(dout + DO_Q), (const bf16*)(dout + DO_K), (const bf16*)(dout + DO_VT), (const bf16*)(dout + DO_GA), (bf16*)(ws + WS_Y), args.in[4],
               (LAS float*)lds, gw, NGW, tid, lane);
#endif
#endif
    __syncthreads();
}
__device__ __forceinline__ void ph3(unsigned char* ws, LAS unsigned char* lds, int G, int bx) {
    pg8::Gemm g{(const bf16*)(ws + WS_Y), (const bf16*)(ws + WS_WP), M, D, D, 8, 1024}; pg8::SplitKOrder S; S.B.init(M, D, G, bx);
    pg8::EpiMerge E{(const bf16*)(ws + WS_GTA), (const bf16*)(ws + WS_GTB), (bf16*)(ws + WS_MRG)};
    pg8::gemm_phase<pg8::EpiMerge, pg8::SplitKOrder, PG8_ALIGN, PG8_SP2>(lds, g, S, E);
}
__device__ __forceinline__ void ph4(const Args& args, unsigned char* ws, LAS unsigned char* lds, int G, int bx) {
    pg8::Gemm g{(const bf16*)(ws + WS_MRG), (const bf16*)(ws + WS_WO), M, D, D, D / 64, 0}; pg8::StaticOrder S; S.init(M, D, G, bx);
    pg8::EpiOut E{args.in[0], args.in[12], args.out, (float*)(ws + WS_ROWSS)};
    pg8::gemm_phase<pg8::EpiOut, pg8::StaticOrder, PG8_ALIGN, PG8_SP2>(lds, g, S, E);
}

__global__ void __launch_bounds__(NWAVES * 64, 2) fwd_mega(Args args) {
    extern __shared__ __attribute__((aligned(16))) unsigned char lds_raw[];
    LAS unsigned char* lds = (LAS unsigned char*)lds_raw;
    cg::grid_group grid = cg::this_grid();
    const int tid = threadIdx.x, lane = tid & 63, wave = __builtin_amdgcn_readfirstlane(tid >> 6);
    const int G = gridDim.x, bx = blockIdx.x;
    const int gw = bx * NWAVES + wave, NGW = G * NWAVES;
    unsigned char* ws = args.ws; unsigned char* dout = (unsigned char*)args.out;
    const int lo = args.ph_lo, hi = args.ph_hi;
    volatile LAS unsigned* bst = (volatile LAS unsigned*)(lds + LDS_BYTES - 64);
    if (tid < 2) bst[tid] = 0u;
    __syncthreads();
    XcdBarrier bar; bar.bar = (unsigned*)ws; bar.x = 0; bar.st = nullptr;
    if (hi - lo > 1) bar = xcd_barrier_post((unsigned*)ws, bst);
#ifndef PH_MASK
#define PH_MASK 63
#endif
#define IN(k) (((PH_MASK >> (k)) & 1) && lo <= (k) && (k) < hi)
#define SEAM(k) do { if (IN(k) && IN((k) + 1)) { if ((k) == 0) { \
    asm volatile("s_waitcnt vmcnt(0)" ::: "memory"); __syncthreads(); \
    if (tid == 0) { __builtin_amdgcn_fence(__ATOMIC_RELEASE, "agent"); asm volatile("s_waitcnt vmcnt(0)" ::: "memory"); } \
    grid.sync(); \
    if (tid == 0) { __builtin_amdgcn_fence(__ATOMIC_ACQUIRE, "agent"); asm volatile("s_waitcnt vmcnt(0)" ::: "memory"); } \
    __syncthreads(); } else xcd_barrier(bar); } } while (0)
#define REPS(k) ((k) == REP_PHASE)

    if (IN(0)) { p0_prologue(args, lds, gw, NGW, wave, lane); if (REPS(0)) p0_prologue(args, lds, gw, NGW, wave, lane); __syncthreads(); }
    SEAM(0);
    if (IN(1)) { ph1(ws, dout, args.in[3], lds, G, bx); if (REPS(1)) ph1(ws, dout, args.in[3], lds, G, bx); }
    SEAM(1);
    if (IN(2)) { ph2(args, ws, dout, lds, G, bx, gw, NGW, tid, wave, lane); if (REPS(2)) ph2(args, ws, dout, lds, G, bx, gw, NGW, tid, wave, lane); }
    SEAM(2);
    if (IN(3)) { ph3(ws, lds, G, bx); if (REPS(3)) ph3(ws, lds, G, bx); }
    SEAM(3);
    if (IN(4)) { ph4(args, ws, lds, G, bx); if (REPS(4)) ph4(args, ws, lds, G, bx); }
    SEAM(4);
    if (IN(5)) final_phase(args.out, (const float*)(ws + WS_ROWSS), gw, NGW, lane);
#undef IN
#undef SEAM
#undef REPS
}

#ifndef MK_N_LAUNCHES
#define MK_N_LAUNCHES 1
#endif
extern "C" void kernel_launch(void* const* d_in, const int* in_sizes, int n_in, void* d_out, int out_size, void* d_ws, size_t ws_size, hipStream_t stream) {
    static int grid = 0;
    if (grid == 0) {
        if (n_in != 13 || in_sizes[0] != M * D || out_size != M * D || ws_size < WS_END) { fprintf(stderr, "kernel_launch: unexpected shapes (n_in %d, in0 %d, out %d, ws %zu); nothing launched\n", n_in, n_in > 0 ? in_sizes[0] : -1, out_size, ws_size); grid = -1; return; }
        int dev = 0, cus = 0, per_cu = 0;
        if (hipGetDevice(&dev) != hipSuccess || hipDeviceGetAttribute(&cus, hipDeviceAttributeMultiprocessorCount, dev) != hipSuccess) { fprintf(stderr, "kernel_launch: device query failed\n"); grid = -1; return; }
        if (hipFuncSetAttribute((const void*)fwd_mega, hipFuncAttributeMaxDynamicSharedMemorySize, LDS_BYTES) != hipSuccess) { fprintf(stderr, "kernel_launch: hipFuncSetAttribute failed\n"); grid = -1; return; }
        if (hipOccupancyMaxActiveBlocksPerMultiprocessor(&per_cu, (const void*)fwd_mega, NWAVES * 64, LDS_BYTES) != hipSuccess || per_cu < 1) { fprintf(stderr, "kernel_launch: occupancy query says %d blocks per CU\n", per_cu); per_cu = 1; }
        (void)hipGetLastError();
        grid = cus * per_cu;
        if (grid % 64 != 0) { fprintf(stderr, "kernel_launch: grid %d is not a multiple of 64 (the attention phase keeps one head per workgroup)\n", grid); grid = -1; return; }
    }
    if (grid < 0) return;
    if (hipMemsetAsync(d_ws, 0, 16384, stream) != hipSuccess) { fprintf(stderr, "kernel_launch: hipMemsetAsync failed\n"); return; }
    Args a{};
    for (int i = 0; i < 13; ++i) a.in[i] = (const float*)d_in[i];
    a.out = (float*)d_out; a.ws = (unsigned char*)d_ws;
#if MK_N_LAUNCHES == 1
    a.ph_lo = 0; a.ph_hi = 6;
    void* kargs[] = {&a};
    hipError_t e = hipLaunchCooperativeKernel((const void*)fwd_mega, dim3(grid), dim3(NWAVES * 64), kargs, LDS_BYTES, stream);
    if (e != hipSuccess) fprintf(stderr, "kernel_launch: cooperative launch failed: %s (grid %d)\n", hipGetErrorString(e), grid);
#else
    for (int p = 0; p < 6; ++p) { a.ph_lo = p; a.ph_hi = p + 1; hipLaunchKernelGGL(fwd_mega, dim3(grid), dim3(NWAVES * 64), LDS_BYTES, stream, a); }
#endif
}
```
